# Optimizing an MI355X kernel written in HIP

```python
import math
import jax, jax.numpy as jnp
from jax import lax
import numpy as np

D_MODEL = 1024
BATCH = 4
SEQ = 4096
DEPTH = 1
DEC_BATCH = 32
DEC_SEQ = 2048
PAST_LEN = 128

MIX_WIDTH = D_MODEL
RET_WIDTH = MIX_WIDTH // 2
ATT_WIDTH = MIX_WIDTH - RET_WIDTH
RET_HEADS = 4
RET_HEAD_DIM = RET_WIDTH // RET_HEADS
RET_CHUNK = 128
ATT_Q_HEADS = 8
ATT_KV_HEADS = 2
ATT_GROUP = ATT_Q_HEADS // ATT_KV_HEADS
ATT_HEAD_DIM = ATT_WIDTH // ATT_Q_HEADS
ATT_KV_WIDTH = ATT_KV_HEADS * ATT_HEAD_DIM
Q_BLOCK = 128
GRID_W = 64
ROPE_THETA = 10000.0
EPS = 1e-6
IN_SIZES = (RET_WIDTH, RET_WIDTH, RET_WIDTH, RET_WIDTH, ATT_WIDTH, ATT_KV_WIDTH, ATT_KV_WIDTH, ATT_WIDTH)
IN_COLS = sum(IN_SIZES)

kernel_name = "hybrid_retention_gqa_encoder"


def rms_norm(x, g):
    xf = x.astype(jnp.float32)
    y = xf * lax.rsqrt(jnp.mean(xf * xf, axis=-1, keepdims=True) + EPS)
    return (y * g.astype(jnp.float32)).astype(x.dtype)


def grid_angles(seq_len, head_dim):
    rows = seq_len // GRID_W
    row = jnp.repeat(jnp.arange(rows, dtype=jnp.float32), GRID_W)
    col = jnp.tile(jnp.arange(GRID_W, dtype=jnp.float32), rows)
    half = head_dim // 2
    freqs = ROPE_THETA ** (-jnp.arange(0, half, 2, dtype=jnp.float32) / half)
    return row[:, None] * freqs[None, :], col[:, None] * freqs[None, :]


def rotate(x, ang):
    cos = jnp.cos(ang)[None, :, None, :].astype(x.dtype)
    sin = jnp.sin(ang)[None, :, None, :].astype(x.dtype)
    x1, x2 = jnp.split(x, 2, axis=-1)
    return jnp.concatenate([x1 * cos - x2 * sin, x2 * cos + x1 * sin], axis=-1)


def axial_rope(x, ang_row, ang_col):
    xr, xc = jnp.split(x, 2, axis=-1)
    return jnp.concatenate([rotate(xr, ang_row), rotate(xc, ang_col)], axis=-1)


def retention_one_direction(q, k, v, log_gamma, include_diag):
    b, s, h, dk = q.shape
    dv = v.shape[-1]
    n = s // RET_CHUNK
    qc = q.reshape(b, n, RET_CHUNK, h, dk)
    kc = k.reshape(b, n, RET_CHUNK, h, dk)
    vc = v.reshape(b, n, RET_CHUNK, h, dv)
    pos = jnp.arange(RET_CHUNK, dtype=jnp.float32)
    diff = pos[:, None] - pos[None, :]
    mask = (diff >= 0) if include_diag else (diff > 0)
    dmat = jnp.where(mask[None], jnp.exp(log_gamma[:, None, None] * jnp.maximum(diff, 0.0)[None]), 0.0)
    scores = jnp.einsum('bnchd,bnmhd->bnhcm', qc, kc) * dmat
    intra = jnp.einsum('bnhcm,bnmhe->bnche', scores, vc)
    k_dec = jnp.exp((RET_CHUNK - 1 - pos)[:, None] * log_gamma[None, :])
    states = jnp.einsum('bnchd,bnche->bnhde', kc * k_dec[:, :, None], vc)
    chunk_decay = jnp.exp(RET_CHUNK * log_gamma)[:, None, None]

    def step(r, st):
        return r * chunk_decay + st, r

    _, r_prev = lax.scan(step, jnp.zeros_like(states[:, 0]), jnp.moveaxis(states, 1, 0))
    r_prev = jnp.moveaxis(r_prev, 0, 1)
    q_dec = jnp.exp((pos + 1.0)[:, None] * log_gamma[None, :])
    cross = jnp.einsum('bnchd,bnhde->bnche', qc * q_dec[:, :, None], r_prev)
    return (intra + cross).reshape(b, s, h, dv)


def bidirectional_retention(q, k, v, log_rate_fwd, log_rate_bwd, gn_g):
    dtype = v.dtype
    qf, kf, vf = q.astype(jnp.float32), k.astype(jnp.float32) * (RET_HEAD_DIM ** -0.5), v.astype(jnp.float32)
    lg_f = -jnp.exp(log_rate_fwd.astype(jnp.float32))
    lg_b = -jnp.exp(log_rate_bwd.astype(jnp.float32))
    fwd = retention_one_direction(qf, kf, vf, lg_f, True)
    bwd = jnp.flip(retention_one_direction(jnp.flip(qf, 1), jnp.flip(kf, 1), jnp.flip(vf, 1), lg_b, False), 1)
    o = fwd + bwd
    o = o * lax.rsqrt(jnp.mean(o * o, axis=-1, keepdims=True) + EPS) * gn_g.astype(jnp.float32)
    b, s = o.shape[:2]
    return o.reshape(b, s, RET_WIDTH).astype(dtype)


def blocked_gqa(q, k, v):
    b, s, _, d = q.shape
    nb = s // Q_BLOCK
    qb = jnp.moveaxis(q.reshape(b, nb, Q_BLOCK, ATT_KV_HEADS, ATT_GROUP, d), 1, 0)
    scale = 1.0 / math.sqrt(d)

    def one_block(qi):
        sc = jnp.einsum('bqkgd,bskd->bkgqs', qi, k).astype(jnp.float32) * scale
        p = jax.nn.softmax(sc, axis=-1).astype(v.dtype)
        return jnp.einsum('bkgqs,bskd->bqkgd', p, v)

    out = lax.map(one_block, qb)
    return jnp.moveaxis(out, 0, 1).reshape(b, s, ATT_WIDTH)


def hybrid_layer(x, c, norm_g, w_ada, b_ada, w_in, log_rate_fwd, log_rate_bwd, gn_g, q_norm_g, k_norm_g, w_out):
    b, s, _ = x.shape
    mod = jax.nn.silu(c) @ w_ada + b_ada
    shift, scale, gate = jnp.split(mod, 3, axis=-1)
    h = rms_norm(x, norm_g) * (1.0 + scale[:, None, :]) + shift[:, None, :]
    proj = h @ w_in
    splits = list(np.cumsum(IN_SIZES)[:-1])
    rq, rk, rv, rg, aq, ak, av, ag = jnp.split(proj, splits, axis=-1)

    ang_r_ret, ang_c_ret = grid_angles(s, RET_HEAD_DIM)
    ang_r_att, ang_c_att = grid_angles(s, ATT_HEAD_DIM)

    rq = axial_rope(rq.reshape(b, s, RET_HEADS, RET_HEAD_DIM), ang_r_ret, ang_c_ret)
    rk = axial_rope(rk.reshape(b, s, RET_HEADS, RET_HEAD_DIM), ang_r_ret, ang_c_ret)
    rv = rv.reshape(b, s, RET_HEADS, RET_HEAD_DIM)
    ret_out = bidirectional_retention(rq, rk, rv, log_rate_fwd, log_rate_bwd, gn_g)

    aq = axial_rope(rms_norm(aq.reshape(b, s, ATT_Q_HEADS, ATT_HEAD_DIM), q_norm_g), ang_r_att, ang_c_att)
    ak = axial_rope(rms_norm(ak.reshape(b, s, ATT_KV_HEADS, ATT_HEAD_DIM), k_norm_g), ang_r_att, ang_c_att)
    av = av.reshape(b, s, ATT_KV_HEADS, ATT_HEAD_DIM)
    att_out = blocked_gqa(aq, ak, av)

    mixed = jnp.concatenate([ret_out * jax.nn.silu(rg), att_out * jax.nn.silu(ag)], axis=-1) @ w_out
    return x + gate[:, None, :] * mixed


def trunk(x, c, norm_g, w_ada, b_ada, w_in, ret_log_rate_fwd, ret_log_rate_bwd, ret_gn_g, q_norm_g, k_norm_g, w_out):
    for l in range(DEPTH):
        x = hybrid_layer(x, c, norm_g[l], w_ada[l], b_ada[l], w_in[l], ret_log_rate_fwd[l], ret_log_rate_bwd[l],
                         ret_gn_g[l], q_norm_g[l], k_norm_g[l], w_out[l])
    return x


def setup_inputs(seed: int = 0) -> dict:
    key = jax.random.key(seed)
    ks = jax.random.split(key, 15)
    f32 = jnp.float32
    base_rate = jnp.log(-jnp.log1p(-(2.0 ** (-5.0 - jnp.arange(RET_HEADS, dtype=f32)))))
    return {
        "x_prompt": jax.random.normal(ks[0], (BATCH, SEQ, D_MODEL), f32),
        "x_sample": jax.random.normal(ks[1], (DEC_BATCH, DEC_SEQ, D_MODEL), f32),
        "c_prompt": jax.random.normal(ks[2], (BATCH, D_MODEL), f32),
        "c_sample": jax.random.normal(ks[3], (DEC_BATCH, D_MODEL), f32),
        "norm_g": 1.0 + 0.02 * jax.random.normal(ks[4], (DEPTH, D_MODEL), f32),
        "w_ada": 0.5 * D_MODEL ** -0.5 * jax.random.normal(ks[5], (DEPTH, D_MODEL, 3 * D_MODEL), f32),
        "b_ada": 0.02 * jax.random.normal(ks[6], (DEPTH, 3 * D_MODEL), f32),
        "w_in": D_MODEL ** -0.5 * jax.random.normal(ks[7], (DEPTH, D_MODEL, IN_COLS), f32),
        "ret_log_rate_fwd": base_rate[None, :] + 0.05 * jax.random.normal(ks[8], (DEPTH, RET_HEADS), f32),
        "ret_log_rate_bwd": base_rate[None, :] + 0.05 * jax.random.normal(ks[9], (DEPTH, RET_HEADS), f32),
        "ret_gn_g": 1.0 + 0.02 * jax.random.normal(ks[10], (DEPTH, RET_HEADS, RET_HEAD_DIM), f32),
        "q_norm_g": 1.0 + 0.02 * jax.random.normal(ks[11], (DEPTH, ATT_HEAD_DIM), f32),
        "k_norm_g": 1.0 + 0.02 * jax.random.normal(ks[12], (DEPTH, ATT_HEAD_DIM), f32),
        "w_out": MIX_WIDTH ** -0.5 * jax.random.normal(ks[13], (DEPTH, MIX_WIDTH, D_MODEL), f32),
    }


def reference(x_prompt, x_sample, c_prompt, c_sample, norm_g, w_ada, b_ada, w_in, ret_log_rate_fwd, ret_log_rate_bwd,
              ret_gn_g, q_norm_g, k_norm_g, w_out):
    y_prompt = trunk(x_prompt, c_prompt, norm_g, w_ada, b_ada, w_in, ret_log_rate_fwd, ret_log_rate_bwd, ret_gn_g,
                     q_norm_g, k_norm_g, w_out)
    y_sample = trunk(x_sample, c_sample, norm_g, w_ada, b_ada, w_in, ret_log_rate_fwd, ret_log_rate_bwd, ret_gn_g,
                     q_norm_g, k_norm_g, w_out)
    return (y_prompt, y_sample)
```

```cpp
#include <hip/hip_runtime.h>
#include <hip/hip_cooperative_groups.h>
#include <cstdio>
#include <cstdint>
namespace cg = cooperative_groups;

typedef unsigned short bf16;
constexpr int DM = 1024, NTOK_P = 4 * 4096, NTOK_S = 32 * 2048, M = NTOK_P + NTOK_S;
constexpr int NB = 36, INC = 3328;
constexpr float EPS = 1e-6f;
constexpr float C2 = 0.125f * 1.4426950408889634f;
constexpr float RK_SCALE = 0.08838834764831845f;
constexpr size_t MiB = 1u << 20;
constexpr size_t WS_CTL = 0, CTL_BYTES = 1 * MiB;
constexpr size_t WS_MOD = 1 * MiB;
constexpr size_t WS_TAB = 2 * MiB;
constexpr size_t WS_WIN = 4 * MiB;
constexpr size_t WS_WOUT = 12 * MiB;
constexpr size_t WS_H = 16 * MiB;
constexpr size_t WS_MIX = WS_H;
constexpr size_t WS_PROJ = 176 * MiB;
constexpr size_t WS_RT = 696 * MiB;
constexpr size_t WS_END = 856 * MiB;

__device__ __forceinline__ unsigned f2bf(float f) { unsigned u = __builtin_bit_cast(unsigned, f); return (u + 0x7fffu + ((u >> 16) & 1u)) >> 16; }
__device__ __forceinline__ unsigned pk2(float lo, float hi) { return f2bf(lo) | (f2bf(hi) << 16); }
__device__ __forceinline__ float bf2f(unsigned short h) { return __builtin_bit_cast(float, (unsigned)h << 16); }
__device__ __forceinline__ float silu(float v) { return v / (1.f + __expf(-v)); }
__device__ __forceinline__ int batch_of(int m) { return m < NTOK_P ? (m >> 12) : 4 + ((m - NTOK_P) >> 11); }
__device__ __forceinline__ int tpos_of(int m) { return m < NTOK_P ? (m & 4095) : (m & 2047); }
#define FAST_RET 1
#define FAST_ATT 1
namespace pg8 {
#define PG8_LAS __attribute__((address_space(3)))
typedef unsigned short bf16_t;
typedef short bf16x8 __attribute__((ext_vector_type(8)));
typedef float f32x4 __attribute__((ext_vector_type(4)));
typedef unsigned u32x4 __attribute__((ext_vector_type(4)));
constexpr int BM = 256, BK = 64, HALF = 128, HTB = HALF * BK * 2  , STAGE_BYTES = 8 * HTB, NXCD = 8, WGM = 8;

__host__ __device__ __forceinline__ int lds_byte(int r, int c) { const int st = (r >> 4) * 2 + (c >> 5), rr = r & 15, cc = c & 31, ob = rr * 64 + cc * 2; return st * 1024 + (ob ^ (((ob >> 9) & 1) << 5)); }
__host__ __device__ __forceinline__ void stage_rc(int b, int& R, int& C) { const int st = b / 1024, sb = b % 1024, swz = sb ^ (((sb >> 9) & 1) << 5); R = (st >> 1) * 16 + swz / 64; C = (st & 1) * 32 + (swz % 64) / 2; }
__host__ __device__ __forceinline__ int perm32(int rho) { const int n = rho >> 4, i = rho & 15; return 8 * (i >> 2) + 4 * n + (i & 3); }

struct Unit { int pm, pn; };
struct Gemm { const bf16_t* A; const bf16_t* Bt; int M, N, K; };

struct StaticOrder {
    int nM, nN, nwg, G, c;
    __host__ __device__ void init(int M, int N, int G_, int c_) { nM = M / BM; nN = N / BM; nwg = nM * nN; G = G_; c = c_; }
    __host__ __device__ bool next(int i, Unit& u) const {
        const long L = (long)i * G + c; if (L >= nwg) return false;
        int wgid = (int)L; { const int q = nwg / NXCD, r = nwg % NXCD, xcd = wgid % NXCD, off = wgid / NXCD; wgid = (xcd < r ? xcd * (q + 1) : r * (q + 1) + (xcd - r) * q) + off; }
        const int nig = WGM * nN, gid = wgid / nig, fm = gid * WGM, gsz = (nM - fm) < WGM ? (nM - fm) : WGM;
        u.pm = fm + ((wgid % nig) % gsz); u.pn = (wgid % nig) / gsz; return true;
    }
    __device__ __forceinline__ void a_ready(const Unit&) const {}
    __device__ __forceinline__ void done(const Unit&) const {}
};
__device__ __forceinline__ unsigned cvt_pk_bf16(float lo, float hi) { unsigned r; asm volatile("v_cvt_pk_bf16_f32 %0, %1, %2" : "=v"(r) : "v"(lo), "v"(hi)); return r; }
template <class Epi, class Sched, bool ALIGN_EPI = false, bool SP2 = false>
__device__ __forceinline__ void gemm_phase(PG8_LAS unsigned char* lds, const Gemm g, const Sched& S, const Epi& E) {
    const int tid = threadIdx.x, wid = __builtin_amdgcn_readfirstlane(tid >> 6), lane = tid & 63, wr = wid >> 2, wc = wid & 3, fr = lane & 15, fq = lane >> 4;
    const int K = g.K, nt = K / BK;
    unsigned voffA[2], voffB[2];
#pragma unroll
    for (int i = 0; i < 2; ++i) { int R, C; stage_rc(tid * 16 + i * 8192, R, C); const int Rb = Epi::PERM ? ((R & ~31) + perm32(R & 31)) : R;
        voffA[i] = (unsigned)(R * K + C) * 2u; voffB[i] = (unsigned)(Rb * K + C) * 2u; }
    const size_t kstep = (size_t)(BK * 2);
    const size_t hstep = (size_t)HALF * K * 2;
    const size_t tstep = 2 * hstep;
    const unsigned ldsw = (unsigned)wid * 1024u;
    const int aoff = lds_byte(wr * 64 + fr, fq * 8), boff = lds_byte(wc * 32 + fr, fq * 8);
#define PG8_SA(b, h) (((b) * 2 + (h)) * HTB)
#define PG8_SB(b, h) ((4 + (b) * 2 + (h)) * HTB)
#define PG8_STAGE(bufoff, gbase, voff) do { _Pragma("unroll") for (int _i = 0; _i < 2; ++_i) \
        __builtin_amdgcn_global_load_lds((const unsigned*)((const char*)(gbase) + (voff)[_i]), (PG8_LAS unsigned*)(lds + (bufoff) + ldsw + _i * 8192), 16, 0, 0); } while (0)
#define PG8_LDA(dst, b, h) do { _Pragma("unroll") for (int m = 0; m < 4; ++m) _Pragma("unroll") for (int k = 0; k < 2; ++k) dst[m][k] = *(const PG8_LAS bf16x8*)(lds + PG8_SA(b, h) + aoff + m * 2048 + k * 1024); } while (0)
#define PG8_LDB(dst, b, h) do { _Pragma("unroll") for (int n = 0; n < 2; ++n) _Pragma("unroll") for (int k = 0; k < 2; ++k) dst[n][k] = *(const PG8_LAS bf16x8*)(lds + PG8_SB(b, h) + boff + n * 2048 + k * 1024); } while (0)
#define PG8_MMA(ai, bj, At, Bt) do { __builtin_amdgcn_s_setprio(1); _Pragma("unroll") for (int m = 0; m < 4; ++m) _Pragma("unroll") for (int n = 0; n < 2; ++n) _Pragma("unroll") for (int k = 0; k < 2; ++k) \
        acc[ai][bj][m][n] = __builtin_amdgcn_mfma_f32_16x16x32_bf16(Bt[n][k], At[m][k], acc[ai][bj][m][n], 0, 0, 0); __builtin_amdgcn_s_setprio(0); } while (0)
#define PG8_WAIT_V(n) asm volatile("s_waitcnt vmcnt(" #n ")" ::: "memory")
#define PG8_WAIT_L(n) asm volatile("s_waitcnt lgkmcnt(" #n ")" ::: "memory")
#define PG8_BAR __builtin_amdgcn_s_barrier()
#define PG8_SCHED __builtin_amdgcn_sched_barrier(0)
    Unit cur, nxt; int ui = 0;
    if (!S.next(0, cur)) return;
    f32x4 acc[2][2][4][2];
#pragma unroll
    for (int a = 0; a < 2; ++a)
#pragma unroll
        for (int b = 0; b < 2; ++b)
#pragma unroll
            for (int m = 0; m < 4; ++m)
#pragma unroll
                for (int n = 0; n < 2; ++n) acc[a][b][m][n] = (f32x4){0.f, 0.f, 0.f, 0.f};
    bf16x8 At[4][2], B0[2][2], B1[2][2];
    const char* cA = (const char*)g.A + (size_t)cur.pm * tstep; const char* cB = (const char*)g.Bt + (size_t)cur.pn * tstep;
    S.a_ready(cur);
    if constexpr (SP2) {
        PG8_STAGE(PG8_SB(0, 0), cB, voffB); PG8_STAGE(PG8_SB(0, 1), cB + hstep, voffB); PG8_STAGE(PG8_SA(0, 0), cA, voffA); PG8_STAGE(PG8_SA(0, 1), cA + hstep, voffA);
        if (wr == 1) PG8_BAR;
        PG8_WAIT_V(2); PG8_BAR;
        PG8_STAGE(PG8_SB(1, 0), cB + kstep, voffB); PG8_STAGE(PG8_SA(1, 0), cA + kstep, voffA); PG8_STAGE(PG8_SB(1, 1), cB + hstep + kstep, voffB);
        PG8_WAIT_V(6); PG8_BAR;
    } else {
        PG8_STAGE(PG8_SB(0, 0), cB, voffB); PG8_STAGE(PG8_SA(0, 0), cA, voffA); PG8_STAGE(PG8_SB(0, 1), cB + hstep, voffB); PG8_STAGE(PG8_SA(0, 1), cA + hstep, voffA);
        if (wr == 1) PG8_BAR;
        PG8_WAIT_V(4); PG8_BAR;
        PG8_STAGE(PG8_SB(1, 0), cB + kstep, voffB); PG8_STAGE(PG8_SA(1, 0), cA + kstep, voffA); PG8_STAGE(PG8_SB(1, 1), cB + hstep + kstep, voffB);
        PG8_WAIT_V(6); PG8_BAR;
    }
    for (;;) {
        const bool has_next = S.next(ui + 1, nxt);
        const char* nA = has_next ? (const char*)g.A + (size_t)nxt.pm * tstep : cA; const char* nB = has_next ? (const char*)g.Bt + (size_t)nxt.pn * tstep : cB;
        for (int t = 0; t < nt; t += 2) {
            const bool last = (t == nt - 2);
            const char* a1 = cA + (size_t)(t + 1) * kstep;
            const char* a2 = last ? nA : cA + (size_t)(t + 2) * kstep; const char* b2 = last ? nB : cB + (size_t)(t + 2) * kstep;
            const char* a3 = a2 + kstep; const char* b3 = b2 + kstep;
            if (last && has_next) S.a_ready(nxt);
            if constexpr (SP2) {
            PG8_LDB(B0, 0, 0); PG8_LDB(B1, 0, 1); PG8_SCHED; PG8_LDA(At, 0, 0); PG8_STAGE(PG8_SA(1, 1), a1 + hstep, voffA);
            PG8_WAIT_V(8); PG8_WAIT_L(0); PG8_BAR; PG8_MMA(0, 0, At, B0); PG8_MMA(0, 1, At, B1); PG8_BAR; PG8_SCHED;
            PG8_LDA(At, 0, 1); PG8_STAGE(PG8_SB(0, 0), b2, voffB); PG8_STAGE(PG8_SB(0, 1), b2 + hstep, voffB); PG8_STAGE(PG8_SA(0, 0), a2, voffA);
            PG8_WAIT_V(8); PG8_WAIT_L(0); PG8_BAR; PG8_MMA(1, 0, At, B0); PG8_MMA(1, 1, At, B1); PG8_BAR; PG8_SCHED;
            PG8_LDB(B0, 1, 0); PG8_LDB(B1, 1, 1); PG8_SCHED; PG8_LDA(At, 1, 0); PG8_STAGE(PG8_SA(0, 1), a2 + hstep, voffA);
            PG8_WAIT_V(8); PG8_WAIT_L(0); PG8_BAR; PG8_MMA(0, 0, At, B0); PG8_MMA(0, 1, At, B1); PG8_BAR; PG8_SCHED;
            PG8_LDA(At, 1, 1); PG8_STAGE(PG8_SB(1, 0), b3, voffB); PG8_STAGE(PG8_SB(1, 1), b3 + hstep, voffB); PG8_STAGE(PG8_SA(1, 0), a3, voffA);
            PG8_WAIT_V(8); PG8_WAIT_L(0); PG8_BAR; PG8_MMA(1, 0, At, B0); PG8_MMA(1, 1, At, B1); PG8_BAR; PG8_SCHED;
            } else {
            PG8_LDB(B0, 0, 0); PG8_SCHED; PG8_LDA(At, 0, 0); PG8_STAGE(PG8_SA(1, 1), a1 + hstep, voffA);
            PG8_WAIT_L(8); PG8_BAR; PG8_WAIT_L(0); PG8_MMA(0, 0, At, B0); PG8_BAR; PG8_SCHED;
            PG8_LDB(B1, 0, 1); PG8_STAGE(PG8_SB(0, 0), b2, voffB);
            PG8_BAR; PG8_WAIT_L(0); PG8_MMA(0, 1, At, B1); PG8_BAR;
            PG8_LDA(At, 0, 1); PG8_STAGE(PG8_SA(0, 0), a2, voffA);
            PG8_BAR; PG8_WAIT_L(0); PG8_MMA(1, 0, At, B0); PG8_BAR; PG8_SCHED;
            PG8_STAGE(PG8_SB(0, 1), b2 + hstep, voffB);
            PG8_WAIT_V(6); PG8_BAR; PG8_MMA(1, 1, At, B1); PG8_BAR;
            PG8_LDB(B0, 1, 0); PG8_SCHED; PG8_LDA(At, 1, 0); PG8_STAGE(PG8_SA(0, 1), a2 + hstep, voffA);
            PG8_WAIT_L(8); PG8_BAR; PG8_WAIT_L(0); PG8_MMA(0, 0, At, B0); PG8_BAR; PG8_SCHED;
            PG8_LDB(B1, 1, 1); PG8_STAGE(PG8_SB(1, 0), b3, voffB);
            PG8_BAR; PG8_WAIT_L(0); PG8_MMA(0, 1, At, B1); PG8_BAR;
            PG8_LDA(At, 1, 1); PG8_STAGE(PG8_SA(1, 0), a3, voffA);
            PG8_BAR; PG8_WAIT_L(0); PG8_MMA(1, 0, At, B0); PG8_BAR; PG8_SCHED;
            PG8_STAGE(PG8_SB(1, 1), b3 + hstep, voffB);
            PG8_WAIT_V(6); PG8_BAR; PG8_MMA(1, 1, At, B1); PG8_BAR;
            }
        }
        if constexpr (ALIGN_EPI) { if (wr == 0) PG8_BAR; }
        if constexpr (!Epi::AFTER_DRAIN) { E(acc, cur, wr, wc, fr, fq); S.done(cur); }
        if (!has_next) break;
#pragma unroll
        for (int a = 0; a < 2; ++a)
#pragma unroll
            for (int b = 0; b < 2; ++b)
#pragma unroll
                for (int m = 0; m < 4; ++m)
#pragma unroll
                    for (int n = 0; n < 2; ++n) acc[a][b][m][n] = (f32x4){0.f, 0.f, 0.f, 0.f};
        cur = nxt; cA = nA; cB = nB; ++ui;
        if constexpr (ALIGN_EPI) { if (wr == 1) PG8_BAR; }
    }
    PG8_WAIT_V(0);
    if constexpr (!ALIGN_EPI) { if (wr == 0) PG8_BAR; }
    PG8_BAR;
    if constexpr (Epi::AFTER_DRAIN) { E.fused(acc, cur, wr, wc, fr, fq, lds, wid, lane); S.done(cur); }
#undef PG8_SA
#undef PG8_SB
#undef PG8_STAGE
#undef PG8_LDA
#undef PG8_LDB
#undef PG8_MMA
#undef PG8_WAIT_V
#undef PG8_WAIT_L
#undef PG8_BAR
#undef PG8_SCHED
}
}
namespace pg8 {
typedef unsigned u32x2 __attribute__((ext_vector_type(2)));
__device__ __forceinline__ f32x4 silu4(f32x4 v) { f32x4 o; o[0] = silu(v[0]); o[1] = silu(v[1]); o[2] = silu(v[2]); o[3] = silu(v[3]); return o; }
struct EpiIn {
    static constexpr bool PERM = false, AFTER_DRAIN = false;
    bf16_t* P; const float* tabR; const float* tabA; const float* qng; const float* kng;
    __device__ __forceinline__ void operator()(const f32x4 (&acc)[2][2][4][2], const Unit& u, int wr, int wc, int fr, int fq) const {
        const int g = u.pn * 4 + wc, gc = u.pn * BM + wc * 64;
#pragma unroll
        for (int ai = 0; ai < 2; ++ai)
#pragma unroll
            for (int m = 0; m < 4; ++m) {
                const int row = u.pm * BM + ai * HALF + wr * 64 + m * 16 + fr, t = tpos_of(row), trow = t >> 6, tcol = t & 63;
                bf16_t* out = P + (size_t)row * INC + gc + 4 * fq;
                f32x4 v[2][2];
#pragma unroll
                for (int bj = 0; bj < 2; ++bj)
#pragma unroll
                    for (int n = 0; n < 2; ++n) v[bj][n] = acc[ai][bj][m][n];
                if (g < 16) {
                    const int pos = (g & 1) ? tcol : trow; const float sc = (g >= 8) ? RK_SCALE : 1.f;
#pragma unroll
                    for (int n = 0; n < 2; ++n) { const f32x4 c = *(const f32x4*)(tabR + pos * 32 + 16 * n + 4 * fq), s = *(const f32x4*)(tabR + 2048 + pos * 32 + 16 * n + 4 * fq);
                        const f32x4 x1 = v[0][n], x2 = v[1][n]; v[0][n] = (x1 * c - x2 * s) * sc; v[1][n] = (x2 * c + x1 * s) * sc; }
                } else if (g < 24) {
                } else if (g < 32) {
#pragma unroll
                    for (int bj = 0; bj < 2; ++bj)
#pragma unroll
                        for (int n = 0; n < 2; ++n) v[bj][n] = silu4(v[bj][n]);
                } else if (g < 42) {
                    float ss = 0.f;
#pragma unroll
                    for (int bj = 0; bj < 2; ++bj)
#pragma unroll
                        for (int n = 0; n < 2; ++n) { const f32x4 x = v[bj][n]; ss += (x[0] * x[0] + x[1] * x[1]) + (x[2] * x[2] + x[3] * x[3]); }
                    ss += __shfl_xor(ss, 16); ss += __shfl_xor(ss, 32);
                    const float rn = rsqrtf(ss * (1.f / 64.f) + EPS); const float* gw = (g < 40) ? qng : kng; const float sc = (g < 40) ? C2 : 1.f;
#pragma unroll
                    for (int bj = 0; bj < 2; ++bj)
#pragma unroll
                        for (int n = 0; n < 2; ++n) { const f32x4 w = *(const f32x4*)(gw + 32 * bj + 16 * n + 4 * fq); v[bj][n] = v[bj][n] * rn * w; }
#pragma unroll
                    for (int bj = 0; bj < 2; ++bj) { const int pos = bj ? tcol : trow;
                        const f32x4 c = *(const f32x4*)(tabA + pos * 16 + 4 * fq), s = *(const f32x4*)(tabA + 1024 + pos * 16 + 4 * fq);
                        const f32x4 x1 = v[bj][0], x2 = v[bj][1]; v[bj][0] = (x1 * c - x2 * s) * sc; v[bj][1] = (x2 * c + x1 * s) * sc; }
                } else if (g < 44) {
                } else {
#pragma unroll
                    for (int bj = 0; bj < 2; ++bj)
#pragma unroll
                        for (int n = 0; n < 2; ++n) v[bj][n] = silu4(v[bj][n]);
                }
#pragma unroll
                for (int bj = 0; bj < 2; ++bj)
#pragma unroll
                    for (int n = 0; n < 2; ++n) { u32x2 w; w.x = cvt_pk_bf16(v[bj][n][0], v[bj][n][1]); w.y = cvt_pk_bf16(v[bj][n][2], v[bj][n][3]); *(u32x2*)(out + 32 * bj + 16 * n) = w; }
            }
    }
};
struct EpiOut {
    static constexpr bool PERM = false, AFTER_DRAIN = false;
    const float* xp; const float* xs; const float* mod; float* y;
    __device__ __forceinline__ void operator()(const f32x4 (&acc)[2][2][4][2], const Unit& u, int wr, int wc, int fr, int fq) const {
        const int row0 = u.pm * BM, b = batch_of(row0); const float* gate = mod + b * 3072 + 2048;
        const float* xb = row0 < NTOK_P ? xp + (size_t)row0 * DM : xs + (size_t)(row0 - NTOK_P) * DM;
        f32x4 gv[2][2];
#pragma unroll
        for (int bj = 0; bj < 2; ++bj)
#pragma unroll
            for (int n = 0; n < 2; ++n) gv[bj][n] = *(const f32x4*)(gate + u.pn * BM + bj * HALF + wc * 32 + 16 * n + 4 * fq);
#pragma unroll
        for (int ai = 0; ai < 2; ++ai)
#pragma unroll
            for (int m = 0; m < 4; ++m) { const int r = ai * HALF + wr * 64 + m * 16 + fr;
#pragma unroll
                for (int bj = 0; bj < 2; ++bj)
#pragma unroll
                    for (int n = 0; n < 2; ++n) { const int c = u.pn * BM + bj * HALF + wc * 32 + 16 * n + 4 * fq;
                        const f32x4 xv = *(const f32x4*)(xb + (size_t)r * DM + c); *(f32x4*)(y + (size_t)(row0 + r) * DM + c) = xv + gv[bj][n] * acc[ai][bj][m][n]; } }
    }
};
}
#include <hip/hip_bf16.h>
#include <cmath>
namespace attn_body {
using bf16=__hip_bfloat16;
using bf16x8=__attribute__((ext_vector_type(8)))short;
using s16x4=__attribute__((ext_vector_type(4)))short;
using f32x16=__attribute__((ext_vector_type(16)))float;
using u32x4=__attribute__((ext_vector_type(4)))unsigned;
constexpr int D=64,DM=3328,OPITCH=1024;
constexpr int NW=8,QBLK=32,QB=QBLK*NW,KVBLK=64;
constexpr int ATTN_PITCH=DM, ATTN_UNIT_ROWS=QB;
__device__ __forceinline__ int crow(int r,int hi){return (r&3)+8*(r>>2)+4*hi;}
#define SBAR() __builtin_amdgcn_sched_barrier(0)
__device__ __forceinline__ void cmask(f32x16&p0,f32x16&p1,int jb,int qrel,int hi){
  const float NEG=-INFINITY; int kb=64*jb+4*hi;
  #pragma unroll
  for(int r=0;r<16;++r){int kv=kb+(r&3)+8*(r>>2); if(kv>qrel)p0[r]=NEG; if(kv+32>qrel)p1[r]=NEG;}
}

constexpr int NSLOT=3, SLOTB=8192;
constexpr int LDS_K=0, LDS_V=NSLOT*SLOTB, LDS_WS=2*NSLOT*SLOTB, LDS_OST=LDS_WS+NW*64*4, LDS_BYTES=LDS_OST+NW*4096;
constexpr float C2=0.125f*1.4426950408889634f;
__device__ __forceinline__ void glds16(const void*gsrc,unsigned lds_dst){unsigned keep;
  asm volatile("s_mov_b32 %0, m0\n\ts_mov_b32 m0, %2\n\ts_nop 0\n\tglobal_load_lds_dwordx4 %1, off\n\ts_mov_b32 m0, %0":"=&s"(keep):"v"(gsrc),"s"(lds_dst):"memory");}
__device__ __forceinline__ float max3f(float a,float b,float c){float r;asm("v_max3_f32 %0, %1, %2, %3":"=v"(r):"v"(a),"v"(b),"v"(c));return r;}
__device__ __forceinline__ float max2f(float a,float b){float r;asm("v_max_f32_e32 %0, %1, %2":"=v"(r):"v"(a),"v"(b));return r;}
__device__ __forceinline__ float fadd_s(float a,float b){float r;asm("v_add_f32_e32 %0, %1, %2":"=v"(r):"v"(a),"v"(b));return r;}
__device__ __forceinline__ float fsub_s(float a,float b){float r;asm("v_sub_f32_e32 %0, %1, %2":"=v"(r):"v"(a),"v"(b));return r;}
typedef float f32x2_t __attribute__((ext_vector_type(2))); typedef __bf16 bf16x2_t __attribute__((ext_vector_type(2)));
__device__ __forceinline__ unsigned cvtpk_s(float lo,float hi){f32x2_t v={lo,hi};bf16x2_t b=__builtin_convertvector(v,bf16x2_t);return __builtin_bit_cast(unsigned,b);}
#define WAIT_BAR(N) asm volatile("s_waitcnt vmcnt(" #N ") lgkmcnt(0)\n\ts_barrier":::"memory")

__device__ __forceinline__ void qkt(f32x16&p0,f32x16&p1,const char*Kslot,const bf16x8*qr,const f32x16&negm,int r32,int hi){
  const char*kb=Kslot+hi*1024+r32*16;
  #pragma unroll
  for(int d0=0;d0<4;++d0){
    const bf16x8 b0=*reinterpret_cast<const bf16x8*>(kb+d0*2048);
    const bf16x8 b1=*reinterpret_cast<const bf16x8*>(kb+d0*2048+512);
    if(d0==0){p0=__builtin_amdgcn_mfma_f32_32x32x16_bf16(b0,qr[0],negm,0,0,0);p1=__builtin_amdgcn_mfma_f32_32x32x16_bf16(b1,qr[0],negm,0,0,0);}
    else{p0=__builtin_amdgcn_mfma_f32_32x32x16_bf16(b0,qr[d0],p0,0,0,0);p1=__builtin_amdgcn_mfma_f32_32x32x16_bf16(b1,qr[d0],p1,0,0,0);}}
}
typedef __attribute__((address_space(3))) const char* lds_cptr;
typedef short v4i16_t __attribute__((ext_vector_type(4)));
__device__ __forceinline__ void kload8(bf16x8*kf,lds_cptr kp){
  kf[0]=*(const __attribute__((address_space(3))) bf16x8*)(kp);      kf[1]=*(const __attribute__((address_space(3))) bf16x8*)(kp+512);
  kf[2]=*(const __attribute__((address_space(3))) bf16x8*)(kp+2048); kf[3]=*(const __attribute__((address_space(3))) bf16x8*)(kp+2560);
  kf[4]=*(const __attribute__((address_space(3))) bf16x8*)(kp+4096); kf[5]=*(const __attribute__((address_space(3))) bf16x8*)(kp+4608);
  kf[6]=*(const __attribute__((address_space(3))) bf16x8*)(kp+6144); kf[7]=*(const __attribute__((address_space(3))) bf16x8*)(kp+6656);
}
__device__ __forceinline__ void kload2(bf16x8*kf,lds_cptr kp,int j){ kf[2*j]=*(const __attribute__((address_space(3))) bf16x8*)(kp+j*2048); kf[2*j+1]=*(const __attribute__((address_space(3))) bf16x8*)(kp+j*2048+512); }
__device__ __forceinline__ s16x4 vtr(lds_cptr p){ return __builtin_bit_cast(s16x4,__builtin_amdgcn_ds_read_tr16_b64_v4i16((__attribute__((address_space(3))) v4i16_t*)p)); }
__device__ __forceinline__ float rowmax(const f32x16&p0,const f32x16&p1){
  float a=max3f(p0[0],p0[1],p1[0]),b=max3f(p0[2],p0[3],p1[1]);a=max3f(a,p1[2],p1[3]);
  #pragma unroll
  for(int r=4;r<16;r+=4){a=max3f(a,p0[r],p0[r+1]);b=max3f(b,p0[r+2],p0[r+3]);a=max3f(a,p1[r],p1[r+1]);b=max3f(b,p1[r+2],p1[r+3]);}
  const float m=max2f(a,b);
  auto rr=__builtin_amdgcn_permlane32_swap(__float_as_uint(m),__float_as_uint(m),false,false);
  return max2f(__uint_as_float(rr[0]),__uint_as_float(rr[1]));
}
__device__ __forceinline__ void pv(f32x16*o,int vb,bf16x8 pa0,bf16x8 pa1,bf16x8 pa2,bf16x8 pa3){
  #pragma unroll
  for(int d0=0;d0<2;++d0){s16x4 lo[4],hi[4];
    #pragma unroll
    for(int ks=0;ks<4;++ks){
      asm volatile("ds_read_b64_tr_b16 %0,%1 offset:%c2":"=&v"(lo[ks]):"v"(vb),"i"(d0*4096+ks*1024):"memory");
      asm volatile("ds_read_b64_tr_b16 %0,%1 offset:%c2":"=&v"(hi[ks]):"v"(vb),"i"(d0*4096+ks*1024+512):"memory");}
    asm volatile("s_waitcnt lgkmcnt(0)":::"memory");SBAR();
    #define PK(k) (bf16x8){lo[k][0],lo[k][1],lo[k][2],lo[k][3],hi[k][0],hi[k][1],hi[k][2],hi[k][3]}
    o[d0]=__builtin_amdgcn_mfma_f32_32x32x16_bf16(pa0,PK(0),o[d0],0,0,0);
    o[d0]=__builtin_amdgcn_mfma_f32_32x32x16_bf16(pa1,PK(1),o[d0],0,0,0);
    o[d0]=__builtin_amdgcn_mfma_f32_32x32x16_bf16(pa2,PK(2),o[d0],0,0,0);
    o[d0]=__builtin_amdgcn_mfma_f32_32x32x16_bf16(pa3,PK(3),o[d0],0,0,0);
    #undef PK
  }
}

#ifndef ATTN_STORE16
#define ATTN_STORE16(p,v) (*(u32x4*)(p)=(v))
#endif
template<int THRL> __device__ __forceinline__ void attn_unit(long rowbase,int S,int h,int qb,const bf16*__restrict__ P,bf16*O,char*shm){
  const int tid=threadIdx.x,lane=tid&63,r32=lane&31,hi=lane>>5; const int wid=__builtin_amdgcn_readfirstlane(tid>>6);
  const int q0=qb*QB;
  const bf16*Qw=P+(rowbase+q0+wid*QBLK)*DM+2048+h*D;
  const bf16*Kh=P+rowbase*DM+2560+(h>>2)*D,*Vh=P+rowbase*DM+2688+(h>>2)*D;
  const unsigned lds0=(unsigned)(uintptr_t)shm;
  float*wsf=(float*)(shm+LDS_WS)+wid*64;
  const bf16*ksrc=Kh+(long)lane*DM+wid*8;
  const bf16*vsrc=Vh+(long)(16*(wid&3)+(lane>>2))*DM+(wid>>2)*32+(lane&3)*8;
  const unsigned kdst=lds0+LDS_K+wid*1024, vdst=lds0+LDS_V+wid*1024;
  #define DMA_K(t,slot) glds16(ksrc+(long)(t)*KVBLK*DM,(unsigned)__builtin_amdgcn_readfirstlane(kdst+(slot)))
  #define DMA_V(t,slot) glds16(vsrc+(long)(t)*KVBLK*DM,(unsigned)__builtin_amdgcn_readfirstlane(vdst+(slot)))
  const int vb0=(int)(lds0+LDS_V)+((lane>>4)&1)*32+(lane&3)*8+(4*hi+((lane&15)>>2))*64;
  const char*Kbase=shm+LDS_K; bf16x8 kf[8];
  const lds_cptr shm3=(lds_cptr)shm; const lds_cptr kp0=shm3+LDS_K+hi*1024+r32*16; const lds_cptr vp0=shm3+LDS_V+((lane>>4)&1)*32+(lane&3)*8+(4*hi+((lane&15)>>2))*64;
  const int NT=S/KVBLK;
  DMA_K(0,0);DMA_V(0,0);DMA_K(1,SLOTB);
  bf16x8 qr[4];
  #pragma unroll
  for(int d0=0;d0<4;++d0)qr[d0]=*reinterpret_cast<const bf16x8*>(&Qw[(long)r32*DM+d0*16+hi*8]);
  float mhat=0.f,l_reg=0.f;f32x16 o[2];o[0]=f32x16{};o[1]=f32x16{};f32x16 negm=f32x16{};asm volatile("":"+v"(negm));
  #define CMASK(P0,P1,t) do{}while(0)
  bool resc=false;
  #define START(P0,P1) do{ const float rm=rowmax(P0,P1); resc=false; \
    { const float dl=rm; mhat=fadd_s(mhat,dl); \
      _Pragma("unroll") for(int r=0;r<16;++r){P0[r]=fsub_s(P0[r],dl);P1[r]=fsub_s(P1[r],dl);} \
      _Pragma("unroll") for(int r=0;r<16;++r)negm[r]=-mhat; asm volatile("":"+v"(negm)); } \
    _Pragma("unroll") for(int r=0;r<16;++r)P0[r]=__builtin_amdgcn_exp2f(P0[r]); }while(0)
  #define RESC() do{ if(resc){ asm volatile("s_waitcnt lgkmcnt(0)":::"memory"); \
      _Pragma("unroll") for(int d_=0;d_<2;++d_) _Pragma("unroll") for(int r=0;r<16;++r)o[d_][r]*=wsf[crow(r,hi)]; } }while(0)
  f32x16 pA0,pA1,pB0,pB1;
  int sl_prev=0,sl_cur=0,sl_next=SLOTB;
  #define ROT() do{sl_prev=sl_cur;sl_cur=sl_next;sl_next=(sl_next==(NSLOT-1)*SLOTB)?0:sl_next+SLOTB;}while(0)
  DMA_K(2,2*SLOTB);
  WAIT_BAR(3);
  qkt(pA0,pA1,Kbase,qr,negm,r32,hi);asm volatile("s_nop 15\n\ts_nop 7":"+v"(pA0),"+v"(pA1));CMASK(pA0,pA1,0);
  START(pA0,pA1);
  _Pragma("unroll") for(int r=0;r<16;++r)pA1[r]=__builtin_amdgcn_exp2f(pA1[r]);
  WAIT_BAR(0);
  DMA_K(3,0);DMA_V(1,SLOTB);
  ROT();
  kload8(kf,kp0+sl_cur);
  WAIT_BAR(2);
  s16x4 vlo[8],vhi[8]; u32x4 pw0,pw1,pw2,pw3;
  #define PKW(P,B) cvtpk_s(P[B],P[B+1])
  #define PAF(k) __builtin_bit_cast(bf16x8,pw##k)
  #define VFR(i) (bf16x8){vlo[i][0],vlo[i][1],vlo[i][2],vlo[i][3],vhi[i][0],vhi[i][1],vhi[i][2],vhi[i][3]}
  #define PIN(x) asm volatile("":"+v"(x))
  #define MX3(a,b,c) __builtin_fmaxf(__builtin_fmaxf((a),(b)),(c))
  #define GAPA(MF,A0,A1,A2,A3,W0,W1,PW) do{ MF; sacc+=A0; sacc+=A1; sacc+=A2; sacc+=A3; PIN(sacc); W0; W1; PIN(PW); SBAR(); }while(0)
  #define EX(v) __builtin_amdgcn_exp2f(v)
  #define GAPB(MF,X,B) do{ MF; X[B]=EX(X[B]); X[B+1]=EX(X[B+1]); X[B+2]=EX(X[B+2]); X[B+3]=EX(X[B+3]); PIN(X); SBAR(); }while(0)
  #define VRD(i) do{ vlo[i]=vtr(vp_+(((i)>>2)*4096+((i)&3)*1024)); vhi[i]=vtr(vp_+(((i)>>2)*4096+((i)&3)*1024+512)); }while(0)
  #define KRD(G,j) do{ if(G){ kload2(kf,kp0+sl_next,j); SBAR(); } }while(0)
  #define STEP(C0,C1,P0,P1,t,GK,GV,GL) do{ SBAR(); \
    const lds_cptr vp_=vp0+sl_prev; \
    VRD(0); SBAR(); float sacc=(P0[0]+P0[1]); \
    GAPA(C0=__builtin_amdgcn_mfma_f32_32x32x16_bf16(kf[0],qr[0],negm,0,0,0), P0[2],P0[3],P0[4],P0[5],     pw0[0]=PKW(P0,0), pw0[1]=PKW(P0,2), pw0); \
    VRD(4); SBAR(); GAPA(C1=__builtin_amdgcn_mfma_f32_32x32x16_bf16(kf[1],qr[0],negm,0,0,0), P0[6],P0[7],P0[8],P0[9],     pw0[2]=PKW(P0,4), pw0[3]=PKW(P0,6), pw0); \
    VRD(1); SBAR(); GAPA(C0=__builtin_amdgcn_mfma_f32_32x32x16_bf16(kf[2],qr[1],C0,0,0,0),   P0[10],P0[11],P0[12],P0[13], pw1[0]=PKW(P0,8), pw1[1]=PKW(P0,10), pw1); \
    VRD(5); SBAR(); GAPA(C1=__builtin_amdgcn_mfma_f32_32x32x16_bf16(kf[3],qr[1],C1,0,0,0),   P0[14],P0[15],P1[0],P1[1],   pw1[2]=PKW(P0,12),pw1[3]=PKW(P0,14), pw1); \
    VRD(2); SBAR(); GAPA(C0=__builtin_amdgcn_mfma_f32_32x32x16_bf16(kf[4],qr[2],C0,0,0,0),   P1[2],P1[3],P1[4],P1[5],     pw2[0]=PKW(P1,0), pw2[1]=PKW(P1,2), pw2); \
    VRD(6); SBAR(); GAPA(C1=__builtin_amdgcn_mfma_f32_32x32x16_bf16(kf[5],qr[2],C1,0,0,0),   P1[6],P1[7],P1[8],P1[9],     pw2[2]=PKW(P1,4), pw2[3]=PKW(P1,6), pw2); \
    VRD(3); SBAR(); GAPA(C0=__builtin_amdgcn_mfma_f32_32x32x16_bf16(kf[6],qr[3],C0,0,0,0),   P1[10],P1[11],P1[12],P1[13], pw3[0]=PKW(P1,8), pw3[1]=PKW(P1,10), pw3); \
    VRD(7); SBAR(); GAPA(C1=__builtin_amdgcn_mfma_f32_32x32x16_bf16(kf[7],qr[3],C1,0,0,0),   P1[14],P1[15],0.f,0.f,       pw3[2]=PKW(P1,12),pw3[3]=PKW(P1,14), pw3); \
    l_reg+=sacc; \
    if(GK){DMA_K((t)+3,sl_cur);} if(GV){DMA_V((t)+1,sl_next);} \
    CMASK(C0,C1,t); \
    { float a=MX3(C0[0],C0[1],C1[0]),b=MX3(C0[2],C0[3],C1[1]); a=MX3(a,C1[2],C1[3]); \
      _Pragma("unroll") for(int r=4;r<16;r+=4){a=MX3(a,C0[r],C0[r+1]);b=MX3(b,C0[r+2],C0[r+3]);a=MX3(a,C1[r],C1[r+1]);b=MX3(b,C1[r+2],C1[r+3]);} \
      float rm=__builtin_fmaxf(a,b); { auto rr=__builtin_amdgcn_permlane32_swap(__float_as_uint(rm),__float_as_uint(rm),false,false); rm=__builtin_fmaxf(__uint_as_float(rr[0]),__uint_as_float(rr[1])); } \
      resc=false; \
      if(__builtin_expect(__any(rm>(float)THRL),0)){ const float dl=__builtin_fmaxf(rm,0.f); mhat+=dl; \
        _Pragma("unroll") for(int r=0;r<16;++r){C0[r]-=dl;C1[r]-=dl;} \
        _Pragma("unroll") for(int r=0;r<16;++r)negm[r]=-mhat; asm volatile("":"+v"(negm)); \
        const float f=__builtin_amdgcn_exp2f(-dl); l_reg*=f; if(hi==0)wsf[r32]=f; resc=true; } } \
    SBAR(); \
    GAPB(o[0]=__builtin_amdgcn_mfma_f32_32x32x16_bf16(PAF(0),VFR(0),o[0],0,0,0), C0,0); \
    GAPB(o[1]=__builtin_amdgcn_mfma_f32_32x32x16_bf16(PAF(0),VFR(4),o[1],0,0,0), C0,4); \
    KRD(GL,0); GAPB(o[0]=__builtin_amdgcn_mfma_f32_32x32x16_bf16(PAF(1),VFR(1),o[0],0,0,0), C0,8); \
    KRD(GL,1); GAPB(o[1]=__builtin_amdgcn_mfma_f32_32x32x16_bf16(PAF(1),VFR(5),o[1],0,0,0), C0,12); \
    KRD(GL,2); GAPB(o[0]=__builtin_amdgcn_mfma_f32_32x32x16_bf16(PAF(2),VFR(2),o[0],0,0,0), C1,0); \
    KRD(GL,3); GAPB(o[1]=__builtin_amdgcn_mfma_f32_32x32x16_bf16(PAF(2),VFR(6),o[1],0,0,0), C1,4); \
    GAPB(o[0]=__builtin_amdgcn_mfma_f32_32x32x16_bf16(PAF(3),VFR(3),o[0],0,0,0), C1,8); \
    GAPB(o[1]=__builtin_amdgcn_mfma_f32_32x32x16_bf16(PAF(3),VFR(7),o[1],0,0,0), C1,12); \
    }while(0)
  int t=1;
  #undef CMASK
  #define CMASK(P0,P1,t) do{}while(0)
  for(;t+5<NT;t+=2){
    STEP(pB0,pB1,pA0,pA1,t,true,true,true);     WAIT_BAR(2); RESC(); ROT();
    STEP(pA0,pA1,pB0,pB1,t+1,true,true,true);   WAIT_BAR(2); RESC(); ROT();
  }
  #undef CMASK
  #define CMASK(P0,P1,t) do{}while(0)
  #define ENDW(tt) do{ if((tt)+3<NT){WAIT_BAR(2);} else if((tt)+2<NT){WAIT_BAR(1);} else {WAIT_BAR(0);} }while(0)
  for(;t+1<NT;t+=2){
    STEP(pB0,pB1,pA0,pA1,t,(t+3<NT),(t+1<NT),(t+1<NT));       ENDW(t);   RESC(); ROT();
    STEP(pA0,pA1,pB0,pB1,t+1,(t+4<NT),(t+2<NT),(t+2<NT));     ENDW(t+1); RESC(); ROT();
  }
  STEP(pB0,pB1,pA0,pA1,NT-1,false,false,false); RESC();
  { float sacc=pB0[0]+pB0[1]; _Pragma("unroll") for(int r=2;r<16;++r)sacc+=pB0[r]; _Pragma("unroll") for(int r=0;r<16;++r)sacc+=pB1[r]; l_reg+=sacc;
    pw0=(u32x4){PKW(pB0,0),PKW(pB0,2),PKW(pB0,4),PKW(pB0,6)};pw1=(u32x4){PKW(pB0,8),PKW(pB0,10),PKW(pB0,12),PKW(pB0,14)};pw2=(u32x4){PKW(pB1,0),PKW(pB1,2),PKW(pB1,4),PKW(pB1,6)};pw3=(u32x4){PKW(pB1,8),PKW(pB1,10),PKW(pB1,12),PKW(pB1,14)};
    SBAR(); pv(o,vb0+sl_cur,PAF(0),PAF(1),PAF(2),PAF(3)); }
  #undef PKW
  #undef PAF
  #undef VFR
  #undef PIN
  #undef MX3
  #undef GAPA
  #undef GAPB
  #undef EX
  #undef VRD
  #undef KRD
  #undef STEP
  #undef ENDW
  {auto rr=__builtin_amdgcn_permlane32_swap(__float_as_uint(l_reg),__float_as_uint(l_reg),false,false);l_reg=__uint_as_float(rr[0])+__uint_as_float(rr[1]);}
  if(hi==0)wsf[32+r32]=l_reg;asm volatile("s_waitcnt lgkmcnt(0)":::"memory");
  float rli[16];
  #pragma unroll
  for(int r=0;r<16;++r)rli[r]=__builtin_amdgcn_rcpf(wsf[32+crow(r,hi)]);
  bf16*Ow=O+(rowbase+q0+wid*QBLK)*OPITCH+512+h*D; const bf16*Gw=P+(rowbase+q0+wid*QBLK)*DM+2816+h*D;
  { bf16*stg=(bf16*)(shm+LDS_OST)+wid*2048;
    #pragma unroll
    for(int r=0;r<16;++r){const int orow=crow(r,hi);
      #pragma unroll
      for(int d0=0;d0<2;++d0)stg[orow*64+d0*32+r32]=__float2bfloat16(o[d0][r]*rli[r]);}
    asm volatile("s_waitcnt lgkmcnt(0)":::"memory");
    #pragma unroll
    for(int i=0;i<4;++i){const int row=i*8+(lane>>3),ch=lane&7; const u32x4 v=*(const u32x4*)(stg+row*64+ch*8); const u32x4 gt=*(const u32x4*)(Gw+(long)row*DM+ch*8); u32x4 w;
      _Pragma("unroll") for(int e=0;e<4;++e){ const float a0=__uint_as_float(v[e]<<16)*__uint_as_float(gt[e]<<16), a1=__uint_as_float(v[e]&0xffff0000u)*__uint_as_float(gt[e]&0xffff0000u); w[e]=cvtpk_s(a0,a1); }
      ATTN_STORE16(Ow+(long)row*OPITCH+ch*8,w);} }
  asm volatile("s_waitcnt lgkmcnt(0)\n\ts_barrier":::"memory");
  #undef DMA_K
  #undef DMA_V
  #undef CMASK
  #undef START
  #undef RESC
  #undef ROT
}
constexpr int ATTN_LDS_BYTES=LDS_BYTES;
#undef SBAR
#undef WAIT_BAR
}
namespace ret_body {
using attn_body::bf16x8; using attn_body::s16x4; using attn_body::f32x16; using attn_body::u32x4; using attn_body::glds16; using attn_body::vtr; using attn_body::cvtpk_s; using attn_body::crow; using attn_body::lds_cptr;
typedef unsigned u32x2 __attribute__((ext_vector_type(2)));
typedef float f32x4 __attribute__((ext_vector_type(4)));
constexpr int PP = 3328, QOFF = 0, KOFF = 512, VOFF = 1024, GOFF = 1536;
constexpr float LOG2E = 1.4426950408889634f;
#define RB_WAITV0_BAR() asm volatile("s_waitcnt vmcnt(0) lgkmcnt(0)\n\ts_barrier" ::: "memory")
#define RB_BAR() asm volatile("s_waitcnt lgkmcnt(0)\n\ts_barrier" ::: "memory")
__device__ __forceinline__ size_t rt_off(int dir, int cgl, int h) { return ((size_t)(dir * 640 + cgl) * 4 + h) * 32768; }
__device__ __forceinline__ s16x4 scale4(s16x4 v, float w0, float w1, float w2, float w3) {
    const u32x2 u = __builtin_bit_cast(u32x2, v); u32x2 o;
    o[0] = cvtpk_s(__uint_as_float(u[0] << 16) * w0, __uint_as_float(u[0] & 0xffff0000u) * w1);
    o[1] = cvtpk_s(__uint_as_float(u[1] << 16) * w2, __uint_as_float(u[1] & 0xffff0000u) * w3);
    return __builtin_bit_cast(s16x4, o);
}
__device__ __forceinline__ bf16x8 scale8(bf16x8 v, float w) {
    const u32x4 u = __builtin_bit_cast(u32x4, v); u32x4 o;
#pragma unroll
    for (int e = 0; e < 4; ++e) o[e] = cvtpk_s(__uint_as_float(u[e] << 16) * w, __uint_as_float(u[e] & 0xffff0000u) * w);
    return __builtin_bit_cast(bf16x8, o);
}
__device__ __forceinline__ void dma_timg(const bf16* P, long row0, int col0, unsigned dst, int wid, int lane) {
#pragma unroll
    for (int i = 0; i < 4; ++i) { const int p = wid * 4 + i, db = p >> 3, kg = p & 7;
        glds16(P + (row0 + 16 * kg + (lane >> 2)) * PP + col0 + db * 32 + (lane & 3) * 8, (unsigned)__builtin_amdgcn_readfirstlane(dst + p * 1024)); }
}
__device__ __forceinline__ void dma_kimg(const bf16* P, long row0, int col0, unsigned dst, int wid, int lane) {
#pragma unroll
    for (int i = 0; i < 4; ++i) { const int p = wid * 4 + i, c16 = p >> 1, th = p & 1;
        glds16(P + (row0 + 64 * th + lane) * PP + col0 + c16 * 8, (unsigned)__builtin_amdgcn_readfirstlane(dst + p * 1024)); }
}
__device__ __forceinline__ void dma_lin(const unsigned char* src, unsigned dst, int wid, int lane) {
#pragma unroll
    for (int i = 0; i < 4; ++i) { const int p = wid * 4 + i; glds16(src + p * 1024 + lane * 16, (unsigned)__builtin_amdgcn_readfirstlane(dst + p * 1024)); }
}

__device__ __forceinline__ void scan_item(int b, int h, int dir, const bf16* P, unsigned char* RT, const float* lrf, const float* lrb, char* shm) {
    const int tid = threadIdx.x, lane = tid & 63, r32 = lane & 31, hi = lane >> 5; const int wid = __builtin_amdgcn_readfirstlane(tid >> 6);
    const long rowbase = b < 4 ? (long)b * 4096 : (long)NTOK_P + (long)(b - 4) * 2048; const int N = b < 4 ? 32 : 16;
    const unsigned lds0 = (unsigned)(uintptr_t)shm; const lds_cptr shm3 = (lds_cptr)shm;
    const float lg = -__expf(dir ? lrb[h] : lrf[h]) * LOG2E;
    const float gC = exp2f(lg * 128.f);
    const int db = wid & 3, eh = wid >> 2;
    const int troff = ((lane >> 4) & 1) * 32 + (lane & 3) * 8 + (4 * hi + ((lane & 15) >> 2)) * 64;
    f32x16 st[2]; st[0] = f32x16{}; st[1] = f32x16{};
    float wj[8];
#pragma unroll
    for (int j = 0; j < 8; ++j) { const int oj = 8 * (j >> 2) + 4 * hi + (j & 3); wj[j] = exp2f(lg * (float)(dir ? oj : 15 - oj)); }
    const int n0 = dir ? N - 1 : 0, dn = dir ? -1 : 1;
    dma_timg(P, rowbase + (long)n0 * 128, KOFF + h * 128, lds0, wid, lane); dma_timg(P, rowbase + (long)n0 * 128, VOFF + h * 128, lds0 + 32768, wid, lane);
    for (int i = 0; i < N; ++i) {
        const int n = n0 + i * dn, buf = (i & 1) * 65536;
        RB_WAITV0_BAR();
        if (i + 1 < N) { const long r1 = rowbase + (long)(n + dn) * 128; dma_timg(P, r1, KOFF + h * 128, lds0 + (65536 - buf), wid, lane); dma_timg(P, r1, VOFF + h * 128, lds0 + (65536 - buf) + 32768, wid, lane); }
        { unsigned char* img = RT + rt_off(dir, (int)((rowbase >> 7) + n), h);
#pragma unroll
          for (int et = 0; et < 2; ++et) { const int e = 64 * eh + 32 * et + r32;
#pragma unroll
            for (int r4 = 0; r4 < 4; ++r4) { u32x2 w; w[0] = cvtpk_s(st[et][4 * r4], st[et][4 * r4 + 1]); w[1] = cvtpk_s(st[et][4 * r4 + 2], st[et][4 * r4 + 3]);
                *(u32x2*)(img + (4 * db + r4) * 2048 + e * 16 + 8 * hi) = w; }
#pragma unroll
            for (int r = 0; r < 16; ++r) st[et][r] *= gC; } }
        const lds_cptr kb = shm3 + buf + db * 8192 + troff, vb = shm3 + buf + 32768 + (2 * eh) * 8192 + troff;
#pragma unroll
        for (int ks = 0; ks < 8; ++ks) {
            s16x4 klo = vtr(kb + ks * 1024), khi = vtr(kb + ks * 1024 + 512);
            const float bk = exp2f(lg * (float)(dir ? 16 * ks : 112 - 16 * ks));
            float w[8];
#pragma unroll
            for (int j = 0; j < 8; ++j) w[j] = wj[j] * bk;
            klo = scale4(klo, w[0], w[1], w[2], w[3]); khi = scale4(khi, w[4], w[5], w[6], w[7]);
            const bf16x8 af = (bf16x8){klo[0], klo[1], klo[2], klo[3], khi[0], khi[1], khi[2], khi[3]};
#pragma unroll
            for (int et = 0; et < 2; ++et) { const s16x4 vlo = vtr(vb + et * 8192 + ks * 1024), vhi = vtr(vb + et * 8192 + ks * 1024 + 512);
                const bf16x8 bfr = (bf16x8){vlo[0], vlo[1], vlo[2], vlo[3], vhi[0], vhi[1], vhi[2], vhi[3]};
                st[et] = __builtin_amdgcn_mfma_f32_32x32x16_bf16(af, bfr, st[et], 0, 0, 0); }
        }
    }
    RB_BAR();
}

__device__ __forceinline__ void out_item(int cgl, int h, const bf16* P, const unsigned char* RT, bf16* O, const float* lrf, const float* lrb, const float* gng, char* shm) {
    const int tid = threadIdx.x, lane = tid & 63, r32 = lane & 31, hi = lane >> 5; const int wid = __builtin_amdgcn_readfirstlane(tid >> 6);
    const long row0 = (long)cgl * 128; const unsigned lds0 = (unsigned)(uintptr_t)shm; const lds_cptr shm3 = (lds_cptr)shm;
    const float lgf = -__expf(lrf[h]) * LOG2E, lgb = -__expf(lrb[h]) * LOG2E;
    const int rb = wid & 3, dh = wid >> 2, c = 32 * rb + r32;
    dma_kimg(P, row0, KOFF + h * 128, lds0, wid, lane); dma_timg(P, row0, VOFF + h * 128, lds0 + 32768, wid, lane);
    dma_lin(RT + rt_off(0, cgl, h), lds0 + 65536, wid, lane); dma_lin(RT + rt_off(1, cgl, h), lds0 + 98304, wid, lane);
    bf16x8 qr[8];
    { const bf16* Qw = P + (row0 + c) * PP + QOFF + h * 128 + hi * 8;
#pragma unroll
      for (int s = 0; s < 8; ++s) qr[s] = *reinterpret_cast<const bf16x8*>(Qw + 16 * s); }
    RB_WAITV0_BAR();
    f32x16 o[2]; o[0] = f32x16{}; o[1] = f32x16{};
    const int troff = ((lane >> 4) & 1) * 32 + (lane & 3) * 8 + (4 * hi + ((lane & 15) >> 2)) * 64;
    const lds_cptr kp = shm3 + hi * 2048 + r32 * 16, vb = shm3 + 32768 + (2 * dh) * 8192 + troff;
#pragma unroll
    for (int kb = 0; kb < 4; ++kb) {
        f32x16 p = f32x16{};
#pragma unroll
        for (int s = 0; s < 8; ++s) { const bf16x8 kf = *(const __attribute__((address_space(3))) bf16x8*)(kp + s * 4096 + kb * 512); p = __builtin_amdgcn_mfma_f32_32x32x16_bf16(kf, qr[s], p, 0, 0, 0); }
#pragma unroll
        for (int r = 0; r < 16; ++r) { const int m = 32 * kb + crow(r, hi), df = c - m; p[r] *= exp2f(df >= 0 ? lgf * (float)df : lgb * (float)(-df)); }
        u32x4 pw0, pw1;
#pragma unroll
        for (int e = 0; e < 4; ++e) { pw0[e] = cvtpk_s(p[2 * e], p[2 * e + 1]); pw1[e] = cvtpk_s(p[8 + 2 * e], p[8 + 2 * e + 1]); }
#pragma unroll
        for (int d0 = 0; d0 < 2; ++d0) {
            { const s16x4 vlo = vtr(vb + d0 * 8192 + (2 * kb) * 1024), vhi = vtr(vb + d0 * 8192 + (2 * kb) * 1024 + 512);
              o[d0] = __builtin_amdgcn_mfma_f32_32x32x16_bf16(__builtin_bit_cast(bf16x8, pw0), (bf16x8){vlo[0], vlo[1], vlo[2], vlo[3], vhi[0], vhi[1], vhi[2], vhi[3]}, o[d0], 0, 0, 0); }
            { const s16x4 vlo = vtr(vb + d0 * 8192 + (2 * kb + 1) * 1024), vhi = vtr(vb + d0 * 8192 + (2 * kb + 1) * 1024 + 512);
              o[d0] = __builtin_amdgcn_mfma_f32_32x32x16_bf16(__builtin_bit_cast(bf16x8, pw1), (bf16x8){vlo[0], vlo[1], vlo[2], vlo[3], vhi[0], vhi[1], vhi[2], vhi[3]}, o[d0], 0, 0, 0); }
        }
    }
#pragma unroll
    for (int dir = 0; dir < 2; ++dir) {
        const float dec = dir ? exp2f(lgb * (float)(128 - c)) : exp2f(lgf * (float)(c + 1));
        const lds_cptr rp = shm3 + 65536 + dir * 32768 + hi * 2048 + (64 * dh + r32) * 16;
#pragma unroll
        for (int s = 0; s < 8; ++s) { const bf16x8 qs = scale8(qr[s], dec);
#pragma unroll
            for (int d0 = 0; d0 < 2; ++d0) { const bf16x8 rf = *(const __attribute__((address_space(3))) bf16x8*)(rp + s * 4096 + d0 * 512); o[d0] = __builtin_amdgcn_mfma_f32_32x32x16_bf16(qs, rf, o[d0], 0, 0, 0); } }
    }
    float ss[16];
#pragma unroll
    for (int r = 0; r < 16; ++r) { float v = o[0][r] * o[0][r] + o[1][r] * o[1][r]; v += __shfl_xor(v, 1); v += __shfl_xor(v, 2); v += __shfl_xor(v, 4); v += __shfl_xor(v, 8); v += __shfl_xor(v, 16); ss[r] = v; }
    float* part = (float*)(shm + 131072);
    if (r32 == 0) {
#pragma unroll
        for (int r = 0; r < 16; ++r) part[dh * 128 + 32 * rb + crow(r, hi)] = ss[r]; }
    RB_BAR();
    float* stg = (float*)(shm + wid * 8192);
    { const float g0 = gng[h * 128 + 64 * dh + r32], g1 = gng[h * 128 + 64 * dh + 32 + r32];
#pragma unroll
      for (int r = 0; r < 16; ++r) { const int orow = crow(r, hi); const float rs = rsqrtf((part[32 * rb + orow] + part[128 + 32 * rb + orow]) * (1.f / 128.f) + EPS);
          stg[orow * 64 + r32] = o[0][r] * rs * g0; stg[orow * 64 + 32 + r32] = o[1][r] * rs * g1; } }
    asm volatile("s_waitcnt lgkmcnt(0)" ::: "memory");
    { const bf16* Gw = P + (row0 + 32 * rb) * PP + GOFF + h * 128 + 64 * dh; bf16* Ow = O + (row0 + 32 * rb) * 1024 + h * 128 + 64 * dh;
#pragma unroll
      for (int i = 0; i < 4; ++i) { const int row = i * 8 + (lane >> 3), ch = lane & 7; const f32x4 a = *(const f32x4*)(stg + row * 64 + ch * 8), bq = *(const f32x4*)(stg + row * 64 + ch * 8 + 4);
          const u32x4 gt = *(const u32x4*)(Gw + (long)row * PP + ch * 8); u32x4 w;
          w[0] = cvtpk_s(a[0] * __uint_as_float(gt[0] << 16), a[1] * __uint_as_float(gt[0] & 0xffff0000u)); w[1] = cvtpk_s(a[2] * __uint_as_float(gt[1] << 16), a[3] * __uint_as_float(gt[1] & 0xffff0000u));
          w[2] = cvtpk_s(bq[0] * __uint_as_float(gt[2] << 16), bq[1] * __uint_as_float(gt[2] & 0xffff0000u)); w[3] = cvtpk_s(bq[2] * __uint_as_float(gt[3] << 16), bq[3] * __uint_as_float(gt[3] & 0xffff0000u));
          *(u32x4*)(Ow + (long)row * 1024 + ch * 8) = w; } }
    RB_BAR();
}
}
#define LAS __attribute__((address_space(3)))
constexpr int NWAVES = 8, NTHREADS = 512;
constexpr int RING_BYTES = 131072, LDS_BYTES = 147456;
#define LDS_WAIT() asm volatile("s_waitcnt lgkmcnt(0)" ::: "memory")

struct Args { const float* in[14]; float* out; unsigned char* ws; int ph_lo, ph_hi; };

__device__ __forceinline__ void p0_mod_item(const Args& a, LAS unsigned char* lds, int item) {
    const int tid = threadIdx.x, lane = tid & 63, wave = tid >> 6, col = tid & 31, kl = tid >> 5, n0 = item * 32;
    const float* cp = a.in[2]; const float* cs = a.in[3]; const float* W = a.in[5]; const float* bias = a.in[6]; float* mod = (float*)(a.ws + WS_MOD);
    LAS float* sl = (LAS float*)lds;
    LAS float* red = (LAS float*)(lds + 40960);
    float acc[NB];
#pragma unroll
    for (int b = 0; b < NB; ++b) acc[b] = 0.f;
    for (int kc = 0; kc < 4; ++kc) {
        __syncthreads();
        for (int e = tid; e < NB * 256; e += NTHREADS) { const int b = e >> 8, k = e & 255; const float* c = b < 4 ? cp + b * DM : cs + (b - 4) * DM; sl[e] = silu(c[kc * 256 + k]); }
        __syncthreads();
#pragma unroll 4
        for (int i = 0; i < 16; ++i) { const int k = kl + 16 * i; const float w = W[(size_t)(kc * 256 + k) * 3072 + n0 + col];
#pragma unroll
            for (int b = 0; b < NB; ++b) acc[b] += sl[b * 256 + k] * w; }
    }
#pragma unroll
    for (int b = 0; b < NB; ++b) acc[b] += __shfl_xor(acc[b], 32);
    __syncthreads();
    if (lane < 32) {
#pragma unroll
        for (int b = 0; b < NB; ++b) red[(wave * NB + b) * 32 + col] = acc[b]; }
    __syncthreads();
    for (int e = tid; e < NB * 32; e += NTHREADS) { const int b = e >> 5, c = e & 31; float s = 0.f;
        for (int w = 0; w < 8; ++w) s += red[(w * NB + b) * 32 + c];
        mod[b * 3072 + n0 + c] = s + bias[n0 + c]; }
    __syncthreads();
}
__device__ __forceinline__ void p0_transpose_item(const float* W, int K, int N, bf16* WT, bool perm, LAS float* scr, int item, int lane) {
    const int nblk = N / 32, kb = item / nblk, nb = item % nblk, k0 = 64 * kb, n0 = 32 * nb;
    const int p0 = perm ? ((n0 >> 8) * 256 + ((n0 >> 5) & 1) * 128 + ((n0 >> 6) & 3) * 32) : n0;
#pragma unroll 8
    for (int i = 0; i < 32; ++i) { const int kk = 2 * i + (lane >> 5); scr[kk * 33 + (lane & 31)] = W[(size_t)(k0 + kk) * N + n0 + (lane & 31)]; }
    LDS_WAIT(); asm volatile("" ::: "memory");
    const int c = lane & 7;
#pragma unroll
    for (int j = 0; j < 4; ++j) { const int n = (lane >> 3) + 8 * j; const LAS float* s = scr + (8 * c) * 33 + n;
        uint4 o; o.x = pk2(s[0 * 33], s[1 * 33]); o.y = pk2(s[2 * 33], s[3 * 33]); o.z = pk2(s[4 * 33], s[5 * 33]); o.w = pk2(s[6 * 33], s[7 * 33]);
        *(uint4*)(WT + (size_t)(p0 + n) * K + k0 + 8 * c) = o; }
    LDS_WAIT(); asm volatile("" ::: "memory");
}
__device__ __forceinline__ void p0_prologue(const Args& a, LAS unsigned char* lds) {
    const int tid = threadIdx.x, lane = tid & 63, wave = __builtin_amdgcn_readfirstlane(tid >> 6), G = gridDim.x;
    for (int it = blockIdx.x; it < 96; it += G) p0_mod_item(a, lds, it);
    __syncthreads();
    if ((int)blockIdx.x == G - 1) {
        float* tabR = (float*)(a.ws + WS_TAB); float* tabA = tabR + 4096;
        for (int e = tid; e < 2048; e += NTHREADS) { const int pos = e >> 5, i = e & 31; float sn, cs; sincosf((float)pos * powf(10000.f, -(float)i / 32.f), &sn, &cs); tabR[e] = cs; tabR[2048 + e] = sn; }
        for (int e = tid; e < 1024; e += NTHREADS) { const int pos = e >> 4, i = e & 15; float sn, cs; sincosf((float)pos * powf(10000.f, -(float)i / 16.f), &sn, &cs); tabA[e] = cs; tabA[1024 + e] = sn; }
    }
    LAS float* scr = (LAS float*)(lds + wave * 16384);
    const int gw = blockIdx.x * NWAVES + wave, NGW = G * NWAVES;
    constexpr int I_IN = (DM / 64) * (INC / 32), I_OUT = (DM / 64) * (DM / 32);
    for (int it = gw; it < I_IN + I_OUT; it += NGW) {
        if (it < I_IN) p0_transpose_item(a.in[7], DM, INC, (bf16*)(a.ws + WS_WIN), true, scr, it, lane);
        else p0_transpose_item(a.in[13], DM, DM, (bf16*)(a.ws + WS_WOUT), false, scr, it - I_IN, lane);
    }
}
__device__ __forceinline__ void p1_norm(const Args& a) {
    typedef float f4 __attribute__((ext_vector_type(4)));
    const int tid = threadIdx.x, lane = tid & 63, wave = tid >> 6; const int gw = blockIdx.x * NWAVES + wave, NGW = gridDim.x * NWAVES;
    const float* mod = (const float*)(a.ws + WS_MOD); bf16* H = (bf16*)(a.ws + WS_H);
    const int per = (M + NGW - 1) / NGW; int curb = -1; f4 gs[4], sh[4];
    for (int m = gw * per; m < M && m < (gw + 1) * per; ++m) {
        const int b = batch_of(m);
        if (b != curb) { curb = b;
#pragma unroll
            for (int j = 0; j < 4; ++j) { const f4 g = ((const f4*)a.in[4])[lane + 64 * j], sc = ((const f4*)(mod + b * 3072 + 1024))[lane + 64 * j]; gs[j] = g * (1.f + sc); sh[j] = ((const f4*)(mod + b * 3072))[lane + 64 * j]; } }
        const float* x = m < NTOK_P ? a.in[0] + (size_t)m * DM : a.in[1] + (size_t)(m - NTOK_P) * DM;
        f4 v[4]; float s = 0.f;
#pragma unroll
        for (int j = 0; j < 4; ++j) { v[j] = ((const f4*)x)[lane + 64 * j]; s += (v[j][0] * v[j][0] + v[j][1] * v[j][1]) + (v[j][2] * v[j][2] + v[j][3] * v[j][3]); }
#pragma unroll
        for (int o = 1; o < 64; o <<= 1) s += __shfl_xor(s, o);
        const float r = rsqrtf(s * (1.f / DM) + EPS);
        unsigned long long* o8 = (unsigned long long*)(H + (size_t)m * DM) + lane;
#pragma unroll
        for (int j = 0; j < 4; ++j) { const f4 y = v[j] * r * gs[j] + sh[j]; o8[64 * j] = (unsigned long long)pk2(y[0], y[1]) | ((unsigned long long)pk2(y[2], y[3]) << 32); }
    }
}
__device__ __forceinline__ void p3_scan(const Args& a, char* shm) {
    for (int it = blockIdx.x; it < 288; it += gridDim.x) {
        int b, h, dir;
        if (it < 32) { b = it >> 3; h = (it >> 1) & 3; dir = it & 1; } else { const int j = it - 32; b = 4 + (j >> 3); h = (j >> 1) & 3; dir = j & 1; }
        ret_body::scan_item(b, h, dir, (const bf16*)(a.ws + WS_PROJ), a.ws + WS_RT, a.in[8], a.in[9], shm);
    }
}
__device__ __forceinline__ void p4_retout(const Args& a, char* shm) {
    for (int it = blockIdx.x; it < 2560; it += gridDim.x)
        ret_body::out_item(it >> 2, it & 3, (const bf16*)(a.ws + WS_PROJ), a.ws + WS_RT, (bf16*)(a.ws + WS_MIX), a.in[8], a.in[9], a.in[10], shm);
}
__device__ __forceinline__ void p5_attn(const Args& a, char* shm) {
    const int G = gridDim.x; const attn_body::bf16* P = (const attn_body::bf16*)(a.ws + WS_PROJ); attn_body::bf16* O = (attn_body::bf16*)(a.ws + WS_MIX);
    if (G == 256) {
        const int x = blockIdx.x & 7, j = blockIdx.x >> 3;
        for (int i = 0; i < 10; ++i) {
            if (i < 2) { const int u = i * 32 + j, b = x >> 1, kvh = x & 1; attn_body::attn_unit<8>((long)b * 4096, 4096, kvh * 4 + (u & 3), u >> 2, P, O, shm); }
            else { const int gi = x * 8 + (i - 2), b = gi >> 1, kvh = gi & 1; attn_body::attn_unit<8>((long)NTOK_P + (long)b * 2048, 2048, kvh * 4 + (j & 3), j >> 2, P, O, shm); }
        }
    } else {
        for (int it = blockIdx.x; it < 2560; it += G) {
            if (it < 512) { const int b = it >> 7, h = (it >> 4) & 7, qb = it & 15; attn_body::attn_unit<8>((long)b * 4096, 4096, h, qb, P, O, shm); }
            else { const int j = it - 512, b = j >> 6, h = (j >> 3) & 7, qb = j & 7; attn_body::attn_unit<8>((long)NTOK_P + (long)b * 2048, 2048, h, qb, P, O, shm); }
        }
    }
}
__global__ void __launch_bounds__(NTHREADS, 2) mk_fwd(Args a) {
    extern __shared__ __attribute__((aligned(16))) unsigned char lds_raw[];
    LAS unsigned char* lds = (LAS unsigned char*)lds_raw;
    const int lo = a.ph_lo, hi = a.ph_hi;
#define IN(k) (lo <= (k) && (k) < hi)
#define SEAM(k) do { if (IN(k) && IN((k) + 1)) { cg::this_grid().sync(); } } while (0)
    if (IN(0)) { p0_prologue(a, lds); }
    SEAM(0);
    if (IN(1)) { p1_norm(a); }
    SEAM(1);
    if (IN(2)) {
        pg8::Gemm g{(const bf16*)(a.ws + WS_H), (const bf16*)(a.ws + WS_WIN), M, INC, DM}; pg8::StaticOrder S; S.init(M, INC, gridDim.x, (int)blockIdx.x);
        const float* tabR = (const float*)(a.ws + WS_TAB);
        pg8::EpiIn E{(bf16*)(a.ws + WS_PROJ), tabR, tabR + 4096, a.in[11], a.in[12]};
        pg8::gemm_phase<pg8::EpiIn, pg8::StaticOrder, true, true>(lds, g, S, E);
    }
    SEAM(2);
    if (IN(3)) { p3_scan(a, (char*)lds_raw); }
    SEAM(3);
    if (IN(4)) { p4_retout(a, (char*)lds_raw); }
    if (IN(5)) { p5_attn(a, (char*)lds_raw); }
    SEAM(5);
    if (IN(6)) {
        pg8::Gemm g{(const bf16*)(a.ws + WS_MIX), (const bf16*)(a.ws + WS_WOUT), M, DM, DM}; pg8::StaticOrder S; S.init(M, DM, gridDim.x, (int)blockIdx.x);
        pg8::EpiOut E{a.in[0], a.in[1], (const float*)(a.ws + WS_MOD), a.out};
        pg8::gemm_phase<pg8::EpiOut, pg8::StaticOrder, true, true>(lds, g, S, E);
    }
#undef IN
#undef SEAM
}
__global__ void nv_mod(const float* cp, const float* cs, const float* w_ada, const float* b_ada, float* mod) {
    const int idx = blockIdx.x * 256 + threadIdx.x; if (idx >= NB * 3072) return;
    const int b = idx / 3072, n = idx % 3072; const float* c = b < 4 ? cp + b * DM : cs + (b - 4) * DM;
    float acc = 0.f; for (int k = 0; k < DM; ++k) acc += silu(c[k]) * w_ada[(size_t)k * 3072 + n];
    mod[idx] = acc + b_ada[n];
}
__global__ void nv_h(const float* xp, const float* xs, const float* norm_g, const float* mod, bf16* H) {
    const int m = blockIdx.x * 4 + (threadIdx.x >> 6), lane = threadIdx.x & 63;
    const float* x = m < NTOK_P ? xp + (size_t)m * DM : xs + (size_t)(m - NTOK_P) * DM; const int b = batch_of(m);
    float v[16]; float s = 0.f;
    for (int j = 0; j < 16; ++j) { v[j] = x[lane + 64 * j]; s += v[j] * v[j]; }
    for (int o = 1; o < 64; o <<= 1) s += __shfl_xor(s, o);
    const float r = rsqrtf(s * (1.f / DM) + EPS);
    for (int j = 0; j < 16; ++j) { const int k = lane + 64 * j; const float y = v[j] * r * norm_g[k] * (1.f + mod[b * 3072 + 1024 + k]) + mod[b * 3072 + k];
        H[(size_t)m * DM + k] = (bf16)f2bf(y); }
}
template <int MODE> __global__ void __launch_bounds__(256) nv_gemm(const bf16* A, const float* W, int N, bf16* proj, const float* qng, const float* kng,
                                                                   const float* xp, const float* xs, const float* mod, float* y) {
    __shared__ float As[64][17]; __shared__ float Ws[16][64]; __shared__ float Cs[64][65];
    const int tid = threadIdx.x, ty = tid >> 4, tx = tid & 15, m0 = blockIdx.x * 64, n0 = blockIdx.y * 64;
    float acc[4][4] = {};
    for (int k0 = 0; k0 < DM; k0 += 16) {
        { const int r = tid >> 2, kq = (tid & 3) * 4; const bf16* a = A + (size_t)(m0 + r) * DM + k0 + kq; for (int i = 0; i < 4; ++i) As[r][kq + i] = bf2f(a[i]); }
        { const int k = tid >> 4, n = (tid & 15) * 4; const float* w = W + (size_t)(k0 + k) * N + n0 + n; for (int i = 0; i < 4; ++i) Ws[k][n + i] = w[i]; }
        __syncthreads();
        for (int kk = 0; kk < 16; ++kk) { float a[4], b[4]; for (int i = 0; i < 4; ++i) { a[i] = As[ty * 4 + i][kk]; b[i] = Ws[kk][tx * 4 + i]; }
            for (int i = 0; i < 4; ++i) for (int j = 0; j < 4; ++j) acc[i][j] += a[i] * b[j]; }
        __syncthreads();
    }
    if (MODE == 1) {
        for (int i = 0; i < 4; ++i) { const int m = m0 + ty * 4 + i, b = batch_of(m); const float* x = m < NTOK_P ? xp + (size_t)m * DM : xs + (size_t)(m - NTOK_P) * DM;
            for (int j = 0; j < 4; ++j) { const int n = n0 + tx * 4 + j; y[(size_t)m * DM + n] = x[n] + mod[b * 3072 + 2048 + n] * acc[i][j]; } }
        return;
    }
    for (int i = 0; i < 4; ++i) for (int j = 0; j < 4; ++j) Cs[ty * 4 + i][tx * 4 + j] = acc[i][j];
    __syncthreads();
    const int g = blockIdx.y, r = tid >> 2, q4 = tid & 3, m = m0 + r, t = tpos_of(m), trow = t >> 6, tcol = t & 63;
    bf16* out = proj + (size_t)m * INC + n0;
    const bool is_rq = g < 8, is_rk = g >= 8 && g < 16, is_aq = g >= 32 && g < 40, is_ak = g == 40 || g == 41;
    const bool is_silu = (g >= 24 && g < 32) || g >= 44;
    if (is_rq || is_rk) {
        const float pos = (g & 1) ? (float)tcol : (float)trow; const float sc = is_rk ? 0.08838834764831845f : 1.f;
        for (int ii = 0; ii < 8; ++ii) { const int i = q4 * 8 + ii; const float fr = powf(10000.f, -(float)i / 32.f); float sn, cs; sincosf(pos * fr, &sn, &cs);
            const float x1 = Cs[r][i], x2 = Cs[r][i + 32]; out[i] = (bf16)f2bf((x1 * cs - x2 * sn) * sc); out[i + 32] = (bf16)f2bf((x2 * cs + x1 * sn) * sc); }
    } else if (is_aq || is_ak) {
        float ss = 0.f; for (int d = 0; d < 64; ++d) ss += Cs[r][d] * Cs[r][d];
        const float rn = rsqrtf(ss * (1.f / 64.f) + EPS); const float* gw = is_aq ? qng : kng; const float sc = is_aq ? C2 : 1.f;
        for (int ii = 0; ii < 8; ++ii) { const int p = q4 * 8 + ii, half = p >> 4, i = p & 15, d1 = half * 32 + i, d2 = d1 + 16;
            const float pos = half ? (float)tcol : (float)trow; const float fr = powf(10000.f, -(float)i / 16.f); float sn, cs; sincosf(pos * fr, &sn, &cs);
            const float x1 = Cs[r][d1] * rn * gw[d1], x2 = Cs[r][d2] * rn * gw[d2];
            out[d1] = (bf16)f2bf((x1 * cs - x2 * sn) * sc); out[d2] = (bf16)f2bf((x2 * cs + x1 * sn) * sc); }
    } else {
        for (int ii = 0; ii < 16; ++ii) { const int d = q4 * 16 + ii; const float v = Cs[r][d]; out[d] = (bf16)f2bf(is_silu ? silu(v) : v); }
    }
}
template <int RET> __global__ void __launch_bounds__(256) nv_mix(const bf16* proj, bf16* mixed, const float* lrf, const float* lrb, const float* gng) {
    constexpr int D = RET ? 128 : 64, DS = D / 4;
    __shared__ bf16 Qs[64][D + 2]; __shared__ bf16 KVs[64][D + 2]; __shared__ float Ss[64][65]; __shared__ float al[64]; __shared__ float ls[64];
    const int tid = threadIdx.x, h = blockIdx.y, m0 = blockIdx.x * 64;
    const int S = m0 < NTOK_P ? 4096 : 2048, seq0 = m0 & ~(S - 1), t0 = m0 - seq0;
    const int qoff = RET ? 0 : 2048, koff = RET ? 512 : 2560, voff = RET ? 1024 : 2688, goff = RET ? 1536 : 2816, kvh = RET ? h : (h >> 2);
    float lgf = 0.f, lgb = 0.f; if (RET) { lgf = -__expf(lrf[h]) * 1.4426950408889634f; lgb = -__expf(lrb[h]) * 1.4426950408889634f; }
    for (int e = tid; e < 64 * D; e += 256) { const int r = e / D, d = e % D; Qs[r][d] = proj[(size_t)(m0 + r) * INC + qoff + h * D + d]; }
    float O[DS]; for (int i = 0; i < DS; ++i) O[i] = 0.f;
    float mrun = -1e30f, lrun = 0.f;
    const int ty = tid >> 4, tx = tid & 15, prow = tid >> 2, pd0 = (tid & 3) * DS;
    for (int s0 = 0; s0 < S; s0 += 64) {
        __syncthreads();
        for (int e = tid; e < 64 * D; e += 256) { const int r = e / D, d = e % D; KVs[r][d] = proj[(size_t)(seq0 + s0 + r) * INC + koff + kvh * D + d]; }
        __syncthreads();
        { float a[4][4] = {};
          for (int d = 0; d < D; ++d) { float q[4], k[4]; for (int i = 0; i < 4; ++i) { q[i] = bf2f(Qs[ty * 4 + i][d]); k[i] = bf2f(KVs[tx * 4 + i][d]); }
              for (int i = 0; i < 4; ++i) for (int j = 0; j < 4; ++j) a[i][j] += q[i] * k[j]; }
          for (int i = 0; i < 4; ++i) for (int j = 0; j < 4; ++j) { float v = a[i][j];
              if (RET) { const int tq = t0 + ty * 4 + i, sk = s0 + tx * 4 + j; v *= (sk <= tq) ? exp2f(lgf * (float)(tq - sk)) : exp2f(lgb * (float)(sk - tq)); }
              Ss[ty * 4 + i][tx * 4 + j] = v; } }
        __syncthreads();
        for (int e = tid; e < 64 * D; e += 256) { const int r = e / D, d = e % D; KVs[r][d] = proj[(size_t)(seq0 + s0 + r) * INC + voff + kvh * D + d]; }
        if (!RET && tid < 64) { float mx = -1e30f; for (int j = 0; j < 64; ++j) mx = fmaxf(mx, Ss[tid][j]); const float mn = fmaxf(mrun, mx), a = exp2f(mrun - mn);
            float sum = 0.f; for (int j = 0; j < 64; ++j) { const float p = exp2f(Ss[tid][j] - mn); Ss[tid][j] = p; sum += p; }
            lrun = lrun * a + sum; mrun = mn; al[tid] = a; }
        __syncthreads();
        const float a = RET ? 1.f : al[prow];
        for (int i = 0; i < DS; ++i) O[i] *= a;
        for (int j = 0; j < 64; ++j) { const float p = Ss[prow][j]; for (int i = 0; i < DS; ++i) O[i] += p * bf2f(KVs[j][pd0 + i]); }
    }
    if (!RET && tid < 64) ls[tid] = lrun;
    __syncthreads();
    float scale;
    if (RET) { float ss = 0.f; for (int i = 0; i < DS; ++i) ss += O[i] * O[i]; ss += __shfl_xor(ss, 1); ss += __shfl_xor(ss, 2); scale = rsqrtf(ss * (1.f / 128.f) + EPS); }
    else scale = 1.f / ls[prow];
    const size_t row = (size_t)(m0 + prow);
    for (int i = 0; i < DS; ++i) { const int d = pd0 + i; float v = O[i] * scale; if (RET) v *= gng[h * 128 + d];
        v *= bf2f(proj[row * INC + goff + h * D + d]); mixed[row * DM + (RET ? 0 : 512) + h * D + d] = (bf16)f2bf(v); }
}

static void launch_phases(const Args& proto, int lo, int hi, int grid, hipStream_t stream) {
    Args a = proto; a.ph_lo = lo; a.ph_hi = hi;
    hipLaunchKernelGGL(mk_fwd, dim3(grid), dim3(NTHREADS), LDS_BYTES, stream, a);
}
extern "C" void kernel_launch(void* const* d_in, const int* in_sizes, int n_in, void* d_out, int out_size, void* d_ws, size_t ws_size, hipStream_t stream) {
    static int grid = 0;
    if (grid == 0) {
        int dev = 0, cus = 0, per_cu = 0;
        hipGetDevice(&dev); hipDeviceGetAttribute(&cus, hipDeviceAttributeMultiprocessorCount, dev);
        hipFuncSetAttribute((const void*)mk_fwd, hipFuncAttributeMaxDynamicSharedMemorySize, LDS_BYTES);
        hipOccupancyMaxActiveBlocksPerMultiprocessor(&per_cu, (const void*)mk_fwd, NTHREADS, LDS_BYTES);
        if (per_cu < 1) { fprintf(stderr, "kernel_launch: occupancy query says %d blocks/CU\n", per_cu); per_cu = 1; }
        (void)hipGetLastError();
        grid = cus;
        if (ws_size < WS_END) { fprintf(stderr, "kernel_launch: workspace too small (%zu < %zu)\n", ws_size, (size_t)WS_END); grid = -1; }
    }
    if (grid < 0) return;
    Args a{};
    for (int i = 0; i < 14; ++i) a.in[i] = (const float*)d_in[i];
    a.out = (float*)d_out; a.ws = (unsigned char*)d_ws;
    const float* xp = a.in[0]; const float* xs = a.in[1]; const float* cp = a.in[2]; const float* cs = a.in[3];
    const float* norm_g = a.in[4]; const float* w_ada = a.in[5]; const float* b_ada = a.in[6]; const float* w_in = a.in[7];
    const float* lrf = a.in[8]; const float* lrb = a.in[9]; const float* gng = a.in[10]; const float* qng = a.in[11]; const float* kng = a.in[12]; const float* w_out = a.in[13];
    unsigned char* ws = (unsigned char*)d_ws; float* mod = (float*)(ws + WS_MOD); bf16* H = (bf16*)(ws + WS_H); bf16* proj = (bf16*)(ws + WS_PROJ); bf16* mixed = (bf16*)(ws + WS_MIX);
    float* y = (float*)d_out;
    launch_phases(a, 0, 1, grid, stream);
    launch_phases(a, 1, 2, grid, stream);
    launch_phases(a, 2, 3, grid, stream);
#if FAST_RET
    launch_phases(a, 3, 4, grid, stream);
    launch_phases(a, 4, 5, grid, stream);
#else
    nv_mix<1><<<dim3(M / 64, 4), 256, 0, stream>>>(proj, mixed, lrf, lrb, gng);
#endif
#if FAST_ATT
    launch_phases(a, 5, 6, grid, stream);
#else
    nv_mix<0><<<dim3(M / 64, 8), 256, 0, stream>>>(proj, mixed, lrf, lrb, gng);
#endif
    launch_phases(a, 6, 7, grid, stream);
    (void)w_out; (void)qng; (void)kng; (void)xp; (void)xs; (void)mod; (void)y;
    (void)cp; (void)cs; (void)norm_g; (void)w_ada; (void)b_ada; (void)w_in; (void)H;
}
```

```cpp
#include <hip/hip_runtime.h>
#include <hip/hip_cooperative_groups.h>
#include <cstdio>
#include <cstdint>
namespace cg = cooperative_groups;

typedef unsigned short bf16;
constexpr int DM = 1024, NTOK_P = 4 * 4096, NTOK_S = 32 * 2048, M = NTOK_P + NTOK_S;
constexpr int NB = 36, INC = 3328;
constexpr float EPS = 1e-6f;
constexpr float C2 = 0.125f * 1.4426950408889634f;
constexpr float RK_SCALE = 0.08838834764831845f;
constexpr size_t MiB = 1u << 20;
constexpr size_t WS_CTL = 0, CTL_BYTES = 1 * MiB;
constexpr size_t WS_MOD = 1 * MiB;
constexpr size_t WS_TAB = 2 * MiB;
constexpr size_t WS_WIN = 4 * MiB;
constexpr size_t WS_WOUT = 12 * MiB;
constexpr size_t WS_H = 16 * MiB;
constexpr size_t WS_MIX = WS_H;
constexpr size_t WS_PROJ = 176 * MiB;
constexpr size_t WS_RT = 696 * MiB;
constexpr size_t WS_END = 856 * MiB;

__device__ __forceinline__ unsigned f2bf(float f) { unsigned u = __builtin_bit_cast(unsigned, f); return (u + 0x7fffu + ((u >> 16) & 1u)) >> 16; }
__device__ __forceinline__ unsigned pk2(float lo, float hi) { return f2bf(lo) | (f2bf(hi) << 16); }
__device__ __forceinline__ float bf2f(unsigned short h) { return __builtin_bit_cast(float, (unsigned)h << 16); }
__device__ __forceinline__ float silu(float v) { return v / (1.f + __expf(-v)); }
__device__ __forceinline__ int batch_of(int m) { return m < NTOK_P ? (m >> 12) : 4 + ((m - NTOK_P) >> 11); }
__device__ __forceinline__ int tpos_of(int m) { return m < NTOK_P ? (m & 4095) : (m & 2047); }
namespace pg8 {
#define PG8_LAS __attribute__((address_space(3)))
typedef unsigned short bf16_t;
typedef short bf16x8 __attribute__((ext_vector_type(8)));
typedef float f32x4 __attribute__((ext_vector_type(4)));
typedef unsigned u32x4 __attribute__((ext_vector_type(4)));
constexpr int BM = 256, BK = 64, HALF = 128, HTB = HALF * BK * 2  , STAGE_BYTES = 8 * HTB, NXCD = 8, WGM = 8;

__host__ __device__ __forceinline__ int lds_byte(int r, int c) { const int st = (r >> 4) * 2 + (c >> 5), rr = r & 15, cc = c & 31, ob = rr * 64 + cc * 2; return st * 1024 + (ob ^ (((ob >> 9) & 1) << 5)); }
__host__ __device__ __forceinline__ void stage_rc(int b, int& R, int& C) { const int st = b / 1024, sb = b % 1024, swz = sb ^ (((sb >> 9) & 1) << 5); R = (st >> 1) * 16 + swz / 64; C = (st & 1) * 32 + (swz % 64) / 2; }
__host__ __device__ __forceinline__ int perm32(int rho) { const int n = rho >> 4, i = rho & 15; return 8 * (i >> 2) + 4 * n + (i & 3); }

struct Unit { int pm, pn; };
struct Gemm { const bf16_t* A; const bf16_t* Bt; int M, N, K; };

struct StaticOrder {
    int nM, nN, nwg, G, c;
    __host__ __device__ void init(int M, int N, int G_, int c_) { nM = M / BM; nN = N / BM; nwg = nM * nN; G = G_; c = c_; }
    __host__ __device__ bool next(int i, Unit& u) const {
        const long L = (long)i * G + c; if (L >= nwg) return false;
        int wgid = (int)L; { const int q = nwg / NXCD, r = nwg % NXCD, xcd = wgid % NXCD, off = wgid / NXCD; wgid = (xcd < r ? xcd * (q + 1) : r * (q + 1) + (xcd - r) * q) + off; }
        const int nig = WGM * nN, gid = wgid / nig, fm = gid * WGM, gsz = (nM - fm) < WGM ? (nM - fm) : WGM;
        u.pm = fm + ((wgid % nig) % gsz); u.pn = (wgid % nig) / gsz; return true;
    }
    __device__ __forceinline__ void a_ready(const Unit&) const {}
    __device__ __forceinline__ void done(const Unit&) const {}
};
__device__ __forceinline__ unsigned cvt_pk_bf16(float lo, float hi) { unsigned r; asm volatile("v_cvt_pk_bf16_f32 %0, %1, %2" : "=v"(r) : "v"(lo), "v"(hi)); return r; }
template <class Epi, class Sched, bool ALIGN_EPI = false, bool SP2 = false>
__device__ __forceinline__ void gemm_phase(PG8_LAS unsigned char* lds, const Gemm g, const Sched& S, const Epi& E) {
    const int tid = threadIdx.x, wid = __builtin_amdgcn_readfirstlane(tid >> 6), lane = tid & 63, wr = wid >> 2, wc = wid & 3, fr = lane & 15, fq = lane >> 4;
    const int K = g.K, nt = K / BK;
    unsigned voffA[2], voffB[2];
#pragma unroll
    for (int i = 0; i < 2; ++i) { int R, C; stage_rc(tid * 16 + i * 8192, R, C); const int Rb = Epi::PERM ? ((R & ~31) + perm32(R & 31)) : R;
        voffA[i] = (unsigned)(R * K + C) * 2u; voffB[i] = (unsigned)(Rb * K + C) * 2u; }
    const size_t kstep = (size_t)(BK * 2);
    const size_t hstep = (size_t)HALF * K * 2;
    const size_t tstep = 2 * hstep;
    const unsigned ldsw = (unsigned)wid * 1024u;
    const int aoff = lds_byte(wr * 64 + fr, fq * 8), boff = lds_byte(wc * 32 + fr, fq * 8);
#define PG8_SA(b, h) (((b) * 2 + (h)) * HTB)
#define PG8_SB(b, h) ((4 + (b) * 2 + (h)) * HTB)
#define PG8_STAGE(bufoff, gbase, voff) do { _Pragma("unroll") for (int _i = 0; _i < 2; ++_i) \
        __builtin_amdgcn_global_load_lds((const unsigned*)((const char*)(gbase) + (voff)[_i]), (PG8_LAS unsigned*)(lds + (bufoff) + ldsw + _i * 8192), 16, 0, 0); } while (0)
#define PG8_LDA(dst, b, h) do { _Pragma("unroll") for (int m = 0; m < 4; ++m) _Pragma("unroll") for (int k = 0; k < 2; ++k) dst[m][k] = *(const PG8_LAS bf16x8*)(lds + PG8_SA(b, h) + aoff + m * 2048 + k * 1024); } while (0)
#define PG8_LDB(dst, b, h) do { _Pragma("unroll") for (int n = 0; n < 2; ++n) _Pragma("unroll") for (int k = 0; k < 2; ++k) dst[n][k] = *(const PG8_LAS bf16x8*)(lds + PG8_SB(b, h) + boff + n * 2048 + k * 1024); } while (0)
#define PG8_MMA(ai, bj, At, Bt) do { __builtin_amdgcn_s_setprio(1); _Pragma("unroll") for (int m = 0; m < 4; ++m) _Pragma("unroll") for (int n = 0; n < 2; ++n) _Pragma("unroll") for (int k = 0; k < 2; ++k) \
        acc[ai][bj][m][n] = __builtin_amdgcn_mfma_f32_16x16x32_bf16(Bt[n][k], At[m][k], acc[ai][bj][m][n], 0, 0, 0); __builtin_amdgcn_s_setprio(0); } while (0)
#define PG8_WAIT_V(n) asm volatile("s_waitcnt vmcnt(" #n ")" ::: "memory")
#define PG8_WAIT_L(n) asm volatile("s_waitcnt lgkmcnt(" #n ")" ::: "memory")
#define PG8_BAR __builtin_amdgcn_s_barrier()
#define PG8_SCHED __builtin_amdgcn_sched_barrier(0)
    Unit cur, nxt; int ui = 0;
    if (!S.next(0, cur)) return;
    f32x4 acc[2][2][4][2];
#pragma unroll
    for (int a = 0; a < 2; ++a)
#pragma unroll
        for (int b = 0; b < 2; ++b)
#pragma unroll
            for (int m = 0; m < 4; ++m)
#pragma unroll
                for (int n = 0; n < 2; ++n) acc[a][b][m][n] = (f32x4){0.f, 0.f, 0.f, 0.f};
    bf16x8 At[4][2], B0[2][2], B1[2][2];
    const char* cA = (const char*)g.A + (size_t)cur.pm * tstep; const char* cB = (const char*)g.Bt + (size_t)cur.pn * tstep;
    S.a_ready(cur);
    if constexpr (SP2) {
        PG8_STAGE(PG8_SB(0, 0), cB, voffB); PG8_STAGE(PG8_SB(0, 1), cB + hstep, voffB); PG8_STAGE(PG8_SA(0, 0), cA, voffA); PG8_STAGE(PG8_SA(0, 1), cA + hstep, voffA);
        if (wr == 1) PG8_BAR;
        PG8_WAIT_V(2); PG8_BAR;
        PG8_STAGE(PG8_SB(1, 0), cB + kstep, voffB); PG8_STAGE(PG8_SA(1, 0), cA + kstep, voffA); PG8_STAGE(PG8_SB(1, 1), cB + hstep + kstep, voffB);
        PG8_WAIT_V(6); PG8_BAR;
    } else {
        PG8_STAGE(PG8_SB(0, 0), cB, voffB); PG8_STAGE(PG8_SA(0, 0), cA, voffA); PG8_STAGE(PG8_SB(0, 1), cB + hstep, voffB); PG8_STAGE(PG8_SA(0, 1), cA + hstep, voffA);
        if (wr == 1) PG8_BAR;
        PG8_WAIT_V(4); PG8_BAR;
        PG8_STAGE(PG8_SB(1, 0), cB + kstep, voffB); PG8_STAGE(PG8_SA(1, 0), cA + kstep, voffA); PG8_STAGE(PG8_SB(1, 1), cB + hstep + kstep, voffB);
        PG8_WAIT_V(6); PG8_BAR;
    }
    for (;;) {
        const bool has_next = S.next(ui + 1, nxt);
        const char* nA = has_next ? (const char*)g.A + (size_t)nxt.pm * tstep : cA; const char* nB = has_next ? (const char*)g.Bt + (size_t)nxt.pn * tstep : cB;
        for (int t = 0; t < nt; t += 2) {
            const bool last = (t == nt - 2);
            const char* a1 = cA + (size_t)(t + 1) * kstep;
            const char* a2 = last ? nA : cA + (size_t)(t + 2) * kstep; const char* b2 = last ? nB : cB + (size_t)(t + 2) * kstep;
            const char* a3 = a2 + kstep; const char* b3 = b2 + kstep;
            if (last && has_next) S.a_ready(nxt);
            if constexpr (SP2) {
            PG8_LDB(B0, 0, 0); PG8_LDB(B1, 0, 1); PG8_SCHED; PG8_LDA(At, 0, 0); PG8_STAGE(PG8_SA(1, 1), a1 + hstep, voffA);
            PG8_WAIT_V(8); PG8_WAIT_L(0); PG8_BAR; PG8_MMA(0, 0, At, B0); PG8_MMA(0, 1, At, B1); PG8_BAR; PG8_SCHED;
            PG8_LDA(At, 0, 1); PG8_STAGE(PG8_SB(0, 0), b2, voffB); PG8_STAGE(PG8_SB(0, 1), b2 + hstep, voffB); PG8_STAGE(PG8_SA(0, 0), a2, voffA);
            PG8_WAIT_V(8); PG8_WAIT_L(0); PG8_BAR; PG8_MMA(1, 0, At, B0); PG8_MMA(1, 1, At, B1); PG8_BAR; PG8_SCHED;
            PG8_LDB(B0, 1, 0); PG8_LDB(B1, 1, 1); PG8_SCHED; PG8_LDA(At, 1, 0); PG8_STAGE(PG8_SA(0, 1), a2 + hstep, voffA);
            PG8_WAIT_V(8); PG8_WAIT_L(0); PG8_BAR; PG8_MMA(0, 0, At, B0); PG8_MMA(0, 1, At, B1); PG8_BAR; PG8_SCHED;
            PG8_LDA(At, 1, 1); PG8_STAGE(PG8_SB(1, 0), b3, voffB); PG8_STAGE(PG8_SB(1, 1), b3 + hstep, voffB); PG8_STAGE(PG8_SA(1, 0), a3, voffA);
            PG8_WAIT_V(8); PG8_WAIT_L(0); PG8_BAR; PG8_MMA(1, 0, At, B0); PG8_MMA(1, 1, At, B1); PG8_BAR; PG8_SCHED;
            } else {
            PG8_LDB(B0, 0, 0); PG8_SCHED; PG8_LDA(At, 0, 0); PG8_STAGE(PG8_SA(1, 1), a1 + hstep, voffA);
            PG8_WAIT_L(8); PG8_BAR; PG8_WAIT_L(0); PG8_MMA(0, 0, At, B0); PG8_BAR; PG8_SCHED;
            PG8_LDB(B1, 0, 1); PG8_STAGE(PG8_SB(0, 0), b2, voffB);
            PG8_BAR; PG8_WAIT_L(0); PG8_MMA(0, 1, At, B1); PG8_BAR;
            PG8_LDA(At, 0, 1); PG8_STAGE(PG8_SA(0, 0), a2, voffA);
            PG8_BAR; PG8_WAIT_L(0); PG8_MMA(1, 0, At, B0); PG8_BAR; PG8_SCHED;
            PG8_STAGE(PG8_SB(0, 1), b2 + hstep, voffB);
            PG8_WAIT_V(6); PG8_BAR; PG8_MMA(1, 1, At, B1); PG8_BAR;
            PG8_LDB(B0, 1, 0); PG8_SCHED; PG8_LDA(At, 1, 0); PG8_STAGE(PG8_SA(0, 1), a2 + hstep, voffA);
            PG8_WAIT_L(8); PG8_BAR; PG8_WAIT_L(0); PG8_MMA(0, 0, At, B0); PG8_BAR; PG8_SCHED;
            PG8_LDB(B1, 1, 1); PG8_STAGE(PG8_SB(1, 0), b3, voffB);
            PG8_BAR; PG8_WAIT_L(0); PG8_MMA(0, 1, At, B1); PG8_BAR;
            PG8_LDA(At, 1, 1); PG8_STAGE(PG8_SA(1, 0), a3, voffA);
            PG8_BAR; PG8_WAIT_L(0); PG8_MMA(1, 0, At, B0); PG8_BAR; PG8_SCHED;
            PG8_STAGE(PG8_SB(1, 1), b3 + hstep, voffB);
            PG8_WAIT_V(6); PG8_BAR; PG8_MMA(1, 1, At, B1); PG8_BAR;
            }
        }
        if constexpr (ALIGN_EPI) { if (wr == 0) PG8_BAR; }
        if constexpr (!Epi::AFTER_DRAIN) { E(acc, cur, wr, wc, fr, fq); S.done(cur); }
        if (!has_next) break;
#pragma unroll
        for (int a = 0; a < 2; ++a)
#pragma unroll
            for (int b = 0; b < 2; ++b)
#pragma unroll
                for (int m = 0; m < 4; ++m)
#pragma unroll
                    for (int n = 0; n < 2; ++n) acc[a][b][m][n] = (f32x4){0.f, 0.f, 0.f, 0.f};
        cur = nxt; cA = nA; cB = nB; ++ui;
        if constexpr (ALIGN_EPI) { if (wr == 1) PG8_BAR; }
    }
    PG8_WAIT_V(0);
    if constexpr (!ALIGN_EPI) { if (wr == 0) PG8_BAR; }
    PG8_BAR;
    if constexpr (Epi::AFTER_DRAIN) { E.fused(acc, cur, wr, wc, fr, fq, lds, wid, lane); S.done(cur); }
#undef PG8_SA
#undef PG8_SB
#undef PG8_STAGE
#undef PG8_LDA
#undef PG8_LDB
#undef PG8_MMA
#undef PG8_WAIT_V
#undef PG8_WAIT_L
#undef PG8_BAR
#undef PG8_SCHED
}
}
namespace pg8 {
typedef unsigned u32x2 __attribute__((ext_vector_type(2)));
__device__ __forceinline__ f32x4 silu4(f32x4 v) { f32x4 o; o[0] = silu(v[0]); o[1] = silu(v[1]); o[2] = silu(v[2]); o[3] = silu(v[3]); return o; }
struct EpiIn {
    static constexpr bool PERM = false, AFTER_DRAIN = false;
    bf16_t* P; const float* tabR; const float* tabA; const float* qng; const float* kng;
    __device__ __forceinline__ void operator()(const f32x4 (&acc)[2][2][4][2], const Unit& u, int wr, int wc, int fr, int fq) const {
        const int g = u.pn * 4 + wc, gc = u.pn * BM + wc * 64;
#pragma unroll
        for (int ai = 0; ai < 2; ++ai)
#pragma unroll
            for (int m = 0; m < 4; ++m) {
                const int row = u.pm * BM + ai * HALF + wr * 64 + m * 16 + fr, t = tpos_of(row), trow = t >> 6, tcol = t & 63;
                bf16_t* out = P + (size_t)row * INC + gc + 4 * fq;
                f32x4 v[2][2];
#pragma unroll
                for (int bj = 0; bj < 2; ++bj)
#pragma unroll
                    for (int n = 0; n < 2; ++n) v[bj][n] = acc[ai][bj][m][n];
                if (g < 16) {
                    const int pos = (g & 1) ? tcol : trow; const float sc = (g >= 8) ? RK_SCALE : 1.f;
#pragma unroll
                    for (int n = 0; n < 2; ++n) { const f32x4 c = *(const f32x4*)(tabR + pos * 32 + 16 * n + 4 * fq), s = *(const f32x4*)(tabR + 2048 + pos * 32 + 16 * n + 4 * fq);
                        const f32x4 x1 = v[0][n], x2 = v[1][n]; v[0][n] = (x1 * c - x2 * s) * sc; v[1][n] = (x2 * c + x1 * s) * sc; }
                } else if (g < 24) {
                } else if (g < 32) {
#pragma unroll
                    for (int bj = 0; bj < 2; ++bj)
#pragma unroll
                        for (int n = 0; n < 2; ++n) v[bj][n] = silu4(v[bj][n]);
                } else if (g < 42) {
                    float ss = 0.f;
#pragma unroll
                    for (int bj = 0; bj < 2; ++bj)
#pragma unroll
                        for (int n = 0; n < 2; ++n) { const f32x4 x = v[bj][n]; ss += (x[0] * x[0] + x[1] * x[1]) + (x[2] * x[2] + x[3] * x[3]); }
                    ss += __shfl_xor(ss, 16); ss += __shfl_xor(ss, 32);
                    const float rn = rsqrtf(ss * (1.f / 64.f) + EPS); const float* gw = (g < 40) ? qng : kng; const float sc = (g < 40) ? C2 : 1.f;
#pragma unroll
                    for (int bj = 0; bj < 2; ++bj)
#pragma unroll
                        for (int n = 0; n < 2; ++n) { const f32x4 w = *(const f32x4*)(gw + 32 * bj + 16 * n + 4 * fq); v[bj][n] = v[bj][n] * rn * w; }
#pragma unroll
                    for (int bj = 0; bj < 2; ++bj) { const int pos = bj ? tcol : trow;
                        const f32x4 c = *(const f32x4*)(tabA + pos * 16 + 4 * fq), s = *(const f32x4*)(tabA + 1024 + pos * 16 + 4 * fq);
                        const f32x4 x1 = v[bj][0], x2 = v[bj][1]; v[bj][0] = (x1 * c - x2 * s) * sc; v[bj][1] = (x2 * c + x1 * s) * sc; }
                } else if (g < 44) {
                } else {
#pragma unroll
                    for (int bj = 0; bj < 2; ++bj)
#pragma unroll
                        for (int n = 0; n < 2; ++n) v[bj][n] = silu4(v[bj][n]);
                }
#pragma unroll
                for (int bj = 0; bj < 2; ++bj)
#pragma unroll
                    for (int n = 0; n < 2; ++n) { u32x2 w; w.x = cvt_pk_bf16(v[bj][n][0], v[bj][n][1]); w.y = cvt_pk_bf16(v[bj][n][2], v[bj][n][3]); *(u32x2*)(out + 32 * bj + 16 * n) = w; }
            }
    }
};
struct EpiOut {
    static constexpr bool PERM = false, AFTER_DRAIN = false;
    const float* xp; const float* xs; const float* mod; float* y;
    __device__ __forceinline__ void operator()(const f32x4 (&acc)[2][2][4][2], const Unit& u, int wr, int wc, int fr, int fq) const {
        const int row0 = u.pm * BM, b = batch_of(row0); const float* gate = mod + b * 3072 + 2048;
        const float* xb = row0 < NTOK_P ? xp + (size_t)row0 * DM : xs + (size_t)(row0 - NTOK_P) * DM;
        f32x4 gv[2][2];
#pragma unroll
        for (int bj = 0; bj < 2; ++bj)
#pragma unroll
            for (int n = 0; n < 2; ++n) gv[bj][n] = *(const f32x4*)(gate + u.pn * BM + bj * HALF + wc * 32 + 16 * n + 4 * fq);
#pragma unroll
        for (int ai = 0; ai < 2; ++ai)
#pragma unroll
            for (int m = 0; m < 4; ++m) { const int r = ai * HALF + wr * 64 + m * 16 + fr;
#pragma unroll
                for (int bj = 0; bj < 2; ++bj)
#pragma unroll
                    for (int n = 0; n < 2; ++n) { const int c = u.pn * BM + bj * HALF + wc * 32 + 16 * n + 4 * fq;
                        const f32x4 xv = *(const f32x4*)(xb + (size_t)r * DM + c); *(f32x4*)(y + (size_t)(row0 + r) * DM + c) = xv + gv[bj][n] * acc[ai][bj][m][n]; } }
    }
};
}
#include <hip/hip_bf16.h>
#include <cmath>
namespace attn_body {
using bf16=__hip_bfloat16;
using bf16x8=__attribute__((ext_vector_type(8)))short;
using s16x4=__attribute__((ext_vector_type(4)))short;
using f32x16=__attribute__((ext_vector_type(16)))float;
using u32x4=__attribute__((ext_vector_type(4)))unsigned;
constexpr int D=64,DM=3328,OPITCH=1024;
constexpr int NW=8,QBLK=32,QB=QBLK*NW,KVBLK=64;
constexpr int ATTN_PITCH=DM, ATTN_UNIT_ROWS=QB;
__device__ __forceinline__ int crow(int r,int hi){return (r&3)+8*(r>>2)+4*hi;}
#define SBAR() __builtin_amdgcn_sched_barrier(0)
__device__ __forceinline__ void cmask(f32x16&p0,f32x16&p1,int jb,int qrel,int hi){
  const float NEG=-INFINITY; int kb=64*jb+4*hi;
  #pragma unroll
  for(int r=0;r<16;++r){int kv=kb+(r&3)+8*(r>>2); if(kv>qrel)p0[r]=NEG; if(kv+32>qrel)p1[r]=NEG;}
}

constexpr int NSLOT=3, SLOTB=8192;
constexpr int LDS_K=0, LDS_V=NSLOT*SLOTB, LDS_WS=2*NSLOT*SLOTB, LDS_OST=LDS_WS+NW*64*4, LDS_BYTES=LDS_OST+NW*4096;
constexpr float C2=0.125f*1.4426950408889634f;
__device__ __forceinline__ void glds16(const void*gsrc,unsigned lds_dst){unsigned keep;
  asm volatile("s_mov_b32 %0, m0\n\ts_mov_b32 m0, %2\n\ts_nop 0\n\tglobal_load_lds_dwordx4 %1, off\n\ts_mov_b32 m0, %0":"=&s"(keep):"v"(gsrc),"s"(lds_dst):"memory");}
__device__ __forceinline__ float max3f(float a,float b,float c){float r;asm("v_max3_f32 %0, %1, %2, %3":"=v"(r):"v"(a),"v"(b),"v"(c));return r;}
__device__ __forceinline__ float max2f(float a,float b){float r;asm("v_max_f32_e32 %0, %1, %2":"=v"(r):"v"(a),"v"(b));return r;}
__device__ __forceinline__ float fadd_s(float a,float b){float r;asm("v_add_f32_e32 %0, %1, %2":"=v"(r):"v"(a),"v"(b));return r;}
__device__ __forceinline__ float fsub_s(float a,float b){float r;asm("v_sub_f32_e32 %0, %1, %2":"=v"(r):"v"(a),"v"(b));return r;}
typedef float f32x2_t __attribute__((ext_vector_type(2))); typedef __bf16 bf16x2_t __attribute__((ext_vector_type(2)));
__device__ __forceinline__ unsigned cvtpk_s(float lo,float hi){f32x2_t v={lo,hi};bf16x2_t b=__builtin_convertvector(v,bf16x2_t);return __builtin_bit_cast(unsigned,b);}
#define WAIT_BAR(N) asm volatile("s_waitcnt vmcnt(" #N ") lgkmcnt(0)\n\ts_barrier":::"memory")

__device__ __forceinline__ void qkt(f32x16&p0,f32x16&p1,const char*Kslot,const bf16x8*qr,const f32x16&negm,int r32,int hi){
  const char*kb=Kslot+hi*1024+r32*16;
  #pragma unroll
  for(int d0=0;d0<4;++d0){
    const bf16x8 b0=*reinterpret_cast<const bf16x8*>(kb+d0*2048);
    const bf16x8 b1=*reinterpret_cast<const bf16x8*>(kb+d0*2048+512);
    if(d0==0){p0=__builtin_amdgcn_mfma_f32_32x32x16_bf16(b0,qr[0],negm,0,0,0);p1=__builtin_amdgcn_mfma_f32_32x32x16_bf16(b1,qr[0],negm,0,0,0);}
    else{p0=__builtin_amdgcn_mfma_f32_32x32x16_bf16(b0,qr[d0],p0,0,0,0);p1=__builtin_amdgcn_mfma_f32_32x32x16_bf16(b1,qr[d0],p1,0,0,0);}}
}
typedef __attribute__((address_space(3))) const char* lds_cptr;
typedef short v4i16_t __attribute__((ext_vector_type(4)));
__device__ __forceinline__ void kload8(bf16x8*kf,lds_cptr kp){
  kf[0]=*(const __attribute__((address_space(3))) bf16x8*)(kp);      kf[1]=*(const __attribute__((address_space(3))) bf16x8*)(kp+512);
  kf[2]=*(const __attribute__((address_space(3))) bf16x8*)(kp+2048); kf[3]=*(const __attribute__((address_space(3))) bf16x8*)(kp+2560);
  kf[4]=*(const __attribute__((address_space(3))) bf16x8*)(kp+4096); kf[5]=*(const __attribute__((address_space(3))) bf16x8*)(kp+4608);
  kf[6]=*(const __attribute__((address_space(3))) bf16x8*)(kp+6144); kf[7]=*(const __attribute__((address_space(3))) bf16x8*)(kp+6656);
}
__device__ __forceinline__ void kload2(bf16x8*kf,lds_cptr kp,int j){ kf[2*j]=*(const __attribute__((address_space(3))) bf16x8*)(kp+j*2048); kf[2*j+1]=*(const __attribute__((address_space(3))) bf16x8*)(kp+j*2048+512); }
__device__ __forceinline__ s16x4 vtr(lds_cptr p){ return __builtin_bit_cast(s16x4,__builtin_amdgcn_ds_read_tr16_b64_v4i16((__attribute__((address_space(3))) v4i16_t*)p)); }
__device__ __forceinline__ float rowmax(const f32x16&p0,const f32x16&p1){
  float a=max3f(p0[0],p0[1],p1[0]),b=max3f(p0[2],p0[3],p1[1]);a=max3f(a,p1[2],p1[3]);
  #pragma unroll
  for(int r=4;r<16;r+=4){a=max3f(a,p0[r],p0[r+1]);b=max3f(b,p0[r+2],p0[r+3]);a=max3f(a,p1[r],p1[r+1]);b=max3f(b,p1[r+2],p1[r+3]);}
  const float m=max2f(a,b);
  auto rr=__builtin_amdgcn_permlane32_swap(__float_as_uint(m),__float_as_uint(m),false,false);
  return max2f(__uint_as_float(rr[0]),__uint_as_float(rr[1]));
}
__device__ __forceinline__ void pv(f32x16*o,int vb,bf16x8 pa0,bf16x8 pa1,bf16x8 pa2,bf16x8 pa3){
  #pragma unroll
  for(int d0=0;d0<2;++d0){s16x4 lo[4],hi[4];
    #pragma unroll
    for(int ks=0;ks<4;++ks){
      asm volatile("ds_read_b64_tr_b16 %0,%1 offset:%c2":"=&v"(lo[ks]):"v"(vb),"i"(d0*4096+ks*1024):"memory");
      asm volatile("ds_read_b64_tr_b16 %0,%1 offset:%c2":"=&v"(hi[ks]):"v"(vb),"i"(d0*4096+ks*1024+512):"memory");}
    asm volatile("s_waitcnt lgkmcnt(0)":::"memory");SBAR();
    #define PK(k) (bf16x8){lo[k][0],lo[k][1],lo[k][2],lo[k][3],hi[k][0],hi[k][1],hi[k][2],hi[k][3]}
    o[d0]=__builtin_amdgcn_mfma_f32_32x32x16_bf16(pa0,PK(0),o[d0],0,0,0);
    o[d0]=__builtin_amdgcn_mfma_f32_32x32x16_bf16(pa1,PK(1),o[d0],0,0,0);
    o[d0]=__builtin_amdgcn_mfma_f32_32x32x16_bf16(pa2,PK(2),o[d0],0,0,0);
    o[d0]=__builtin_amdgcn_mfma_f32_32x32x16_bf16(pa3,PK(3),o[d0],0,0,0);
    #undef PK
  }
}

#ifndef ATTN_STORE16
#define ATTN_STORE16(p,v) (*(u32x4*)(p)=(v))
#endif
template<int THRL> __device__ __forceinline__ void attn_unit(long rowbase,int S,int h,int qb,const bf16*__restrict__ P,bf16*O,char*shm){
  const int tid=threadIdx.x,lane=tid&63,r32=lane&31,hi=lane>>5; const int wid=__builtin_amdgcn_readfirstlane(tid>>6);
  const int q0=qb*QB;
  const bf16*Qw=P+(rowbase+q0+wid*QBLK)*DM+2048+h*D;
  const bf16*Kh=P+rowbase*DM+2560+(h>>2)*D,*Vh=P+rowbase*DM+2688+(h>>2)*D;
  const unsigned lds0=(unsigned)(uintptr_t)shm;
  float*wsf=(float*)(shm+LDS_WS)+wid*64;
  const bf16*ksrc=Kh+(long)lane*DM+wid*8;
  const bf16*vsrc=Vh+(long)(16*(wid&3)+(lane>>2))*DM+(wid>>2)*32+(lane&3)*8;
  const unsigned kdst=lds0+LDS_K+wid*1024, vdst=lds0+LDS_V+wid*1024;
  #define DMA_K(t,slot) glds16(ksrc+(long)(t)*KVBLK*DM,(unsigned)__builtin_amdgcn_readfirstlane(kdst+(slot)))
  #define DMA_V(t,slot) glds16(vsrc+(long)(t)*KVBLK*DM,(unsigned)__builtin_amdgcn_readfirstlane(vdst+(slot)))
  const int vb0=(int)(lds0+LDS_V)+((lane>>4)&1)*32+(lane&3)*8+(4*hi+((lane&15)>>2))*64;
  const char*Kbase=shm+LDS_K; bf16x8 kf[8];
  const lds_cptr shm3=(lds_cptr)shm; const lds_cptr kp0=shm3+LDS_K+hi*1024+r32*16; const lds_cptr vp0=shm3+LDS_V+((lane>>4)&1)*32+(lane&3)*8+(4*hi+((lane&15)>>2))*64;
  const int NT=S/KVBLK;
  DMA_K(0,0);DMA_V(0,0);DMA_K(1,SLOTB);
  bf16x8 qr[4];
  #pragma unroll
  for(int d0=0;d0<4;++d0)qr[d0]=*reinterpret_cast<const bf16x8*>(&Qw[(long)r32*DM+d0*16+hi*8]);
  float mhat=0.f,l_reg=0.f;f32x16 o[2];o[0]=f32x16{};o[1]=f32x16{};f32x16 negm=f32x16{};asm volatile("":"+v"(negm));
  #define CMASK(P0,P1,t) do{}while(0)
  bool resc=false;
  #define START(P0,P1) do{ const float rm=rowmax(P0,P1); resc=false; \
    { const float dl=rm; mhat=fadd_s(mhat,dl); \
      _Pragma("unroll") for(int r=0;r<16;++r){P0[r]=fsub_s(P0[r],dl);P1[r]=fsub_s(P1[r],dl);} \
      _Pragma("unroll") for(int r=0;r<16;++r)negm[r]=-mhat; asm volatile("":"+v"(negm)); } \
    _Pragma("unroll") for(int r=0;r<16;++r)P0[r]=__builtin_amdgcn_exp2f(P0[r]); }while(0)
  #define RESC() do{ if(resc){ asm volatile("s_waitcnt lgkmcnt(0)":::"memory"); \
      _Pragma("unroll") for(int d_=0;d_<2;++d_) _Pragma("unroll") for(int r=0;r<16;++r)o[d_][r]*=wsf[crow(r,hi)]; } }while(0)
  f32x16 pA0,pA1,pB0,pB1;
  int sl_prev=0,sl_cur=0,sl_next=SLOTB;
  #define ROT() do{sl_prev=sl_cur;sl_cur=sl_next;sl_next=(sl_next==(NSLOT-1)*SLOTB)?0:sl_next+SLOTB;}while(0)
  DMA_K(2,2*SLOTB);
  WAIT_BAR(3);
  qkt(pA0,pA1,Kbase,qr,negm,r32,hi);asm volatile("s_nop 15\n\ts_nop 7":"+v"(pA0),"+v"(pA1));CMASK(pA0,pA1,0);
  START(pA0,pA1);
  _Pragma("unroll") for(int r=0;r<16;++r)pA1[r]=__builtin_amdgcn_exp2f(pA1[r]);
  WAIT_BAR(0);
  DMA_K(3,0);DMA_V(1,SLOTB);
  ROT();
  kload8(kf,kp0+sl_cur);
  WAIT_BAR(2);
  s16x4 vlo[8],vhi[8]; u32x4 pw0,pw1,pw2,pw3;
  #define PKW(P,B) cvtpk_s(P[B],P[B+1])
  #define PAF(k) __builtin_bit_cast(bf16x8,pw##k)
  #define VFR(i) (bf16x8){vlo[i][0],vlo[i][1],vlo[i][2],vlo[i][3],vhi[i][0],vhi[i][1],vhi[i][2],vhi[i][3]}
  #define PIN(x) asm volatile("":"+v"(x))
  #define MX3(a,b,c) __builtin_fmaxf(__builtin_fmaxf((a),(b)),(c))
  #define GAPA(MF,A0,A1,A2,A3,W0,W1,PW) do{ MF; sacc+=A0; sacc+=A1; sacc+=A2; sacc+=A3; PIN(sacc); W0; W1; PIN(PW); SBAR(); }while(0)
  #define EX(v) __builtin_amdgcn_exp2f(v)
  #define GAPB(MF,X,B) do{ MF; X[B]=EX(X[B]); X[B+1]=EX(X[B+1]); X[B+2]=EX(X[B+2]); X[B+3]=EX(X[B+3]); PIN(X); SBAR(); }while(0)
  #define VRD(i) do{ vlo[i]=vtr(vp_+(((i)>>2)*4096+((i)&3)*1024)); vhi[i]=vtr(vp_+(((i)>>2)*4096+((i)&3)*1024+512)); }while(0)
  #define KRD(G,j) do{ if(G){ kload2(kf,kp0+sl_next,j); SBAR(); } }while(0)
  #define STEP(C0,C1,P0,P1,t,GK,GV,GL) do{ SBAR(); \
    const lds_cptr vp_=vp0+sl_prev; \
    VRD(0); SBAR(); float sacc=(P0[0]+P0[1]); \
    GAPA(C0=__builtin_amdgcn_mfma_f32_32x32x16_bf16(kf[0],qr[0],negm,0,0,0), P0[2],P0[3],P0[4],P0[5],     pw0[0]=PKW(P0,0), pw0[1]=PKW(P0,2), pw0); \
    VRD(4); SBAR(); GAPA(C1=__builtin_amdgcn_mfma_f32_32x32x16_bf16(kf[1],qr[0],negm,0,0,0), P0[6],P0[7],P0[8],P0[9],     pw0[2]=PKW(P0,4), pw0[3]=PKW(P0,6), pw0); \
    VRD(1); SBAR(); GAPA(C0=__builtin_amdgcn_mfma_f32_32x32x16_bf16(kf[2],qr[1],C0,0,0,0),   P0[10],P0[11],P0[12],P0[13], pw1[0]=PKW(P0,8), pw1[1]=PKW(P0,10), pw1); \
    VRD(5); SBAR(); GAPA(C1=__builtin_amdgcn_mfma_f32_32x32x16_bf16(kf[3],qr[1],C1,0,0,0),   P0[14],P0[15],P1[0],P1[1],   pw1[2]=PKW(P0,12),pw1[3]=PKW(P0,14), pw1); \
    VRD(2); SBAR(); GAPA(C0=__builtin_amdgcn_mfma_f32_32x32x16_bf16(kf[4],qr[2],C0,0,0,0),   P1[2],P1[3],P1[4],P1[5],     pw2[0]=PKW(P1,0), pw2[1]=PKW(P1,2), pw2); \
    VRD(6); SBAR(); GAPA(C1=__builtin_amdgcn_mfma_f32_32x32x16_bf16(kf[5],qr[2],C1,0,0,0),   P1[6],P1[7],P1[8],P1[9],     pw2[2]=PKW(P1,4), pw2[3]=PKW(P1,6), pw2); \
    VRD(3); SBAR(); GAPA(C0=__builtin_amdgcn_mfma_f32_32x32x16_bf16(kf[6],qr[3],C0,0,0,0),   P1[10],P1[11],P1[12],P1[13], pw3[0]=PKW(P1,8), pw3[1]=PKW(P1,10), pw3); \
    VRD(7); SBAR(); GAPA(C1=__builtin_amdgcn_mfma_f32_32x32x16_bf16(kf[7],qr[3],C1,0,0,0),   P1[14],P1[15],0.f,0.f,       pw3[2]=PKW(P1,12),pw3[3]=PKW(P1,14), pw3); \
    l_reg+=sacc; \
    if(GK){DMA_K((t)+3,sl_cur);} if(GV){DMA_V((t)+1,sl_next);} \
    CMASK(C0,C1,t); \
    { float a=MX3(C0[0],C0[1],C1[0]),b=MX3(C0[2],C0[3],C1[1]); a=MX3(a,C1[2],C1[3]); \
      _Pragma("unroll") for(int r=4;r<16;r+=4){a=MX3(a,C0[r],C0[r+1]);b=MX3(b,C0[r+2],C0[r+3]);a=MX3(a,C1[r],C1[r+1]);b=MX3(b,C1[r+2],C1[r+3]);} \
      float rm=__builtin_fmaxf(a,b); { auto rr=__builtin_amdgcn_permlane32_swap(__float_as_uint(rm),__float_as_uint(rm),false,false); rm=__builtin_fmaxf(__uint_as_float(rr[0]),__uint_as_float(rr[1])); } \
      resc=false; \
      if(__builtin_expect(__any(rm>(float)THRL),0)){ const float dl=__builtin_fmaxf(rm,0.f); mhat+=dl; \
        _Pragma("unroll") for(int r=0;r<16;++r){C0[r]-=dl;C1[r]-=dl;} \
        _Pragma("unroll") for(int r=0;r<16;++r)negm[r]=-mhat; asm volatile("":"+v"(negm)); \
        const float f=__builtin_amdgcn_exp2f(-dl); l_reg*=f; if(hi==0)wsf[r32]=f; resc=true; } } \
    SBAR(); \
    GAPB(o[0]=__builtin_amdgcn_mfma_f32_32x32x16_bf16(PAF(0),VFR(0),o[0],0,0,0), C0,0); \
    GAPB(o[1]=__builtin_amdgcn_mfma_f32_32x32x16_bf16(PAF(0),VFR(4),o[1],0,0,0), C0,4); \
    KRD(GL,0); GAPB(o[0]=__builtin_amdgcn_mfma_f32_32x32x16_bf16(PAF(1),VFR(1),o[0],0,0,0), C0,8); \
    KRD(GL,1); GAPB(o[1]=__builtin_amdgcn_mfma_f32_32x32x16_bf16(PAF(1),VFR(5),o[1],0,0,0), C0,12); \
    KRD(GL,2); GAPB(o[0]=__builtin_amdgcn_mfma_f32_32x32x16_bf16(PAF(2),VFR(2),o[0],0,0,0), C1,0); \
    KRD(GL,3); GAPB(o[1]=__builtin_amdgcn_mfma_f32_32x32x16_bf16(PAF(2),VFR(6),o[1],0,0,0), C1,4); \
    GAPB(o[0]=__builtin_amdgcn_mfma_f32_32x32x16_bf16(PAF(3),VFR(3),o[0],0,0,0), C1,8); \
    GAPB(o[1]=__builtin_amdgcn_mfma_f32_32x32x16_bf16(PAF(3),VFR(7),o[1],0,0,0), C1,12); \
    }while(0)
  int t=1;
  #undef CMASK
  #define CMASK(P0,P1,t) do{}while(0)
  for(;t+5<NT;t+=2){
    STEP(pB0,pB1,pA0,pA1,t,true,true,true);     WAIT_BAR(2); RESC(); ROT();
    STEP(pA0,pA1,pB0,pB1,t+1,true,true,true);   WAIT_BAR(2); RESC(); ROT();
  }
  #undef CMASK
  #define CMASK(P0,P1,t) do{}while(0)
  #define ENDW(tt) do{ if((tt)+3<NT){WAIT_BAR(2);} else if((tt)+2<NT){WAIT_BAR(1);} else {WAIT_BAR(0);} }while(0)
  for(;t+1<NT;t+=2){
    STEP(pB0,pB1,pA0,pA1,t,(t+3<NT),(t+1<NT),(t+1<NT));       ENDW(t);   RESC(); ROT();
    STEP(pA0,pA1,pB0,pB1,t+1,(t+4<NT),(t+2<NT),(t+2<NT));     ENDW(t+1); RESC(); ROT();
  }
  STEP(pB0,pB1,pA0,pA1,NT-1,false,false,false); RESC();
  { float sacc=pB0[0]+pB0[1]; _Pragma("unroll") for(int r=2;r<16;++r)sacc+=pB0[r]; _Pragma("unroll") for(int r=0;r<16;++r)sacc+=pB1[r]; l_reg+=sacc;
    pw0=(u32x4){PKW(pB0,0),PKW(pB0,2),PKW(pB0,4),PKW(pB0,6)};pw1=(u32x4){PKW(pB0,8),PKW(pB0,10),PKW(pB0,12),PKW(pB0,14)};pw2=(u32x4){PKW(pB1,0),PKW(pB1,2),PKW(pB1,4),PKW(pB1,6)};pw3=(u32x4){PKW(pB1,8),PKW(pB1,10),PKW(pB1,12),PKW(pB1,14)};
    SBAR(); pv(o,vb0+sl_cur,PAF(0),PAF(1),PAF(2),PAF(3)); }
  #undef PKW
  #undef PAF
  #undef VFR
  #undef PIN
  #undef MX3
  #undef GAPA
  #undef GAPB
  #undef EX
  #undef VRD
  #undef KRD
  #undef STEP
  #undef ENDW
  {auto rr=__builtin_amdgcn_permlane32_swap(__float_as_uint(l_reg),__float_as_uint(l_reg),false,false);l_reg=__uint_as_float(rr[0])+__uint_as_float(rr[1]);}
  if(hi==0)wsf[32+r32]=l_reg;asm volatile("s_waitcnt lgkmcnt(0)":::"memory");
  float rli[16];
  #pragma unroll
  for(int r=0;r<16;++r)rli[r]=__builtin_amdgcn_rcpf(wsf[32+crow(r,hi)]);
  bf16*Ow=O+(rowbase+q0+wid*QBLK)*OPITCH+512+h*D; const bf16*Gw=P+(rowbase+q0+wid*QBLK)*DM+2816+h*D;
  { bf16*stg=(bf16*)(shm+LDS_OST)+wid*2048;
    #pragma unroll
    for(int r=0;r<16;++r){const int orow=crow(r,hi);
      #pragma unroll
      for(int d0=0;d0<2;++d0)stg[orow*64+d0*32+r32]=__float2bfloat16(o[d0][r]*rli[r]);}
    asm volatile("s_waitcnt lgkmcnt(0)":::"memory");
    #pragma unroll
    for(int i=0;i<4;++i){const int row=i*8+(lane>>3),ch=lane&7; const u32x4 v=*(const u32x4*)(stg+row*64+ch*8); const u32x4 gt=*(const u32x4*)(Gw+(long)row*DM+ch*8); u32x4 w;
      _Pragma("unroll") for(int e=0;e<4;++e){ const float a0=__uint_as_float(v[e]<<16)*__uint_as_float(gt[e]<<16), a1=__uint_as_float(v[e]&0xffff0000u)*__uint_as_float(gt[e]&0xffff0000u); w[e]=cvtpk_s(a0,a1); }
      ATTN_STORE16(Ow+(long)row*OPITCH+ch*8,w);} }
  asm volatile("s_waitcnt lgkmcnt(0)\n\ts_barrier":::"memory");
  #undef DMA_K
  #undef DMA_V
  #undef CMASK
  #undef START
  #undef RESC
  #undef ROT
}
constexpr int ATTN_LDS_BYTES=LDS_BYTES;
#undef SBAR
#undef WAIT_BAR
}
namespace ret_body {
using attn_body::bf16x8; using attn_body::s16x4; using attn_body::f32x16; using attn_body::u32x4; using attn_body::glds16; using attn_body::vtr; using attn_body::cvtpk_s; using attn_body::crow; using attn_body::lds_cptr;
typedef unsigned u32x2 __attribute__((ext_vector_type(2)));
typedef float f32x4 __attribute__((ext_vector_type(4)));
constexpr int PP = 3328, QOFF = 0, KOFF = 512, VOFF = 1024, GOFF = 1536;
constexpr float LOG2E = 1.4426950408889634f;
#define RB_WAITV0_BAR() asm volatile("s_waitcnt vmcnt(0) lgkmcnt(0)\n\ts_barrier" ::: "memory")
#define RB_BAR() asm volatile("s_waitcnt lgkmcnt(0)\n\ts_barrier" ::: "memory")
__device__ __forceinline__ size_t rt_off(int dir, int cgl, int h) { return ((size_t)(dir * 640 + cgl) * 4 + h) * 32768; }
__device__ __forceinline__ s16x4 scale4(s16x4 v, float w0, float w1, float w2, float w3) {
    const u32x2 u = __builtin_bit_cast(u32x2, v); u32x2 o;
    o[0] = cvtpk_s(__uint_as_float(u[0] << 16) * w0, __uint_as_float(u[0] & 0xffff0000u) * w1);
    o[1] = cvtpk_s(__uint_as_float(u[1] << 16) * w2, __uint_as_float(u[1] & 0xffff0000u) * w3);
    return __builtin_bit_cast(s16x4, o);
}
__device__ __forceinline__ bf16x8 scale8(bf16x8 v, float w) {
    const u32x4 u = __builtin_bit_cast(u32x4, v); u32x4 o;
#pragma unroll
    for (int e = 0; e < 4; ++e) o[e] = cvtpk_s(__uint_as_float(u[e] << 16) * w, __uint_as_float(u[e] & 0xffff0000u) * w);
    return __builtin_bit_cast(bf16x8, o);
}
__device__ __forceinline__ void dma_timg(const bf16* P, long row0, int col0, unsigned dst, int wid, int lane) {
#pragma unroll
    for (int i = 0; i < 4; ++i) { const int p = wid * 4 + i, db = p >> 3, kg = p & 7;
        glds16(P + (row0 + 16 * kg + (lane >> 2)) * PP + col0 + db * 32 + (lane & 3) * 8, (unsigned)__builtin_amdgcn_readfirstlane(dst + p * 1024)); }
}
__device__ __forceinline__ void dma_kimg(const bf16* P, long row0, int col0, unsigned dst, int wid, int lane) {
#pragma unroll
    for (int i = 0; i < 4; ++i) { const int p = wid * 4 + i, c16 = p >> 1, th = p & 1;
        glds16(P + (row0 + 64 * th + lane) * PP + col0 + c16 * 8, (unsigned)__builtin_amdgcn_readfirstlane(dst + p * 1024)); }
}
__device__ __forceinline__ void dma_lin(const unsigned char* src, unsigned dst, int wid, int lane) {
#pragma unroll
    for (int i = 0; i < 4; ++i) { const int p = wid * 4 + i; glds16(src + p * 1024 + lane * 16, (unsigned)__builtin_amdgcn_readfirstlane(dst + p * 1024)); }
}

__device__ __forceinline__ void scan_item(int b, int h, int dir, const bf16* P, unsigned char* RT, const float* lrf, const float* lrb, char* shm) {
    const int tid = threadIdx.x, lane = tid & 63, r32 = lane & 31, hi = lane >> 5; const int wid = __builtin_amdgcn_readfirstlane(tid >> 6);
    const long rowbase = b < 4 ? (long)b * 4096 : (long)NTOK_P + (long)(b - 4) * 2048; const int N = b < 4 ? 32 : 16;
    const unsigned lds0 = (unsigned)(uintptr_t)shm; const lds_cptr shm3 = (lds_cptr)shm;
    const float lg = -__expf(dir ? lrb[h] : lrf[h]) * LOG2E;
    const float gC = exp2f(lg * 128.f);
    const int db = wid & 3, eh = wid >> 2;
    const int troff = ((lane >> 4) & 1) * 32 + (lane & 3) * 8 + (4 * hi + ((lane & 15) >> 2)) * 64;
    f32x16 st[2]; st[0] = f32x16{}; st[1] = f32x16{};
    float wj[8];
#pragma unroll
    for (int j = 0; j < 8; ++j) { const int oj = 8 * (j >> 2) + 4 * hi + (j & 3); wj[j] = exp2f(lg * (float)(dir ? oj : 15 - oj)); }
    const int n0 = dir ? N - 1 : 0, dn = dir ? -1 : 1;
    dma_timg(P, rowbase + (long)n0 * 128, KOFF + h * 128, lds0, wid, lane); dma_timg(P, rowbase + (long)n0 * 128, VOFF + h * 128, lds0 + 32768, wid, lane);
    for (int i = 0; i < N; ++i) {
        const int n = n0 + i * dn, buf = (i & 1) * 65536;
        RB_WAITV0_BAR();
        if (i + 1 < N) { const long r1 = rowbase + (long)(n + dn) * 128; dma_timg(P, r1, KOFF + h * 128, lds0 + (65536 - buf), wid, lane); dma_timg(P, r1, VOFF + h * 128, lds0 + (65536 - buf) + 32768, wid, lane); }
        { unsigned char* img = RT + rt_off(dir, (int)((rowbase >> 7) + n), h);
#pragma unroll
          for (int et = 0; et < 2; ++et) { const int e = 64 * eh + 32 * et + r32;
#pragma unroll
            for (int r4 = 0; r4 < 4; ++r4) { u32x2 w; w[0] = cvtpk_s(st[et][4 * r4], st[et][4 * r4 + 1]); w[1] = cvtpk_s(st[et][4 * r4 + 2], st[et][4 * r4 + 3]);
                *(u32x2*)(img + (4 * db + r4) * 2048 + e * 16 + 8 * hi) = w; }
#pragma unroll
            for (int r = 0; r < 16; ++r) st[et][r] *= gC; } }
        const lds_cptr kb = shm3 + buf + db * 8192 + troff, vb = shm3 + buf + 32768 + (2 * eh) * 8192 + troff;
#pragma unroll
        for (int ks = 0; ks < 8; ++ks) {
            s16x4 klo = vtr(kb + ks * 1024), khi = vtr(kb + ks * 1024 + 512);
            const float bk = exp2f(lg * (float)(dir ? 16 * ks : 112 - 16 * ks));
            float w[8];
#pragma unroll
            for (int j = 0; j < 8; ++j) w[j] = wj[j] * bk;
            klo = scale4(klo, w[0], w[1], w[2], w[3]); khi = scale4(khi, w[4], w[5], w[6], w[7]);
            const bf16x8 af = (bf16x8){klo[0], klo[1], klo[2], klo[3], khi[0], khi[1], khi[2], khi[3]};
#pragma unroll
            for (int et = 0; et < 2; ++et) { const s16x4 vlo = vtr(vb + et * 8192 + ks * 1024), vhi = vtr(vb + et * 8192 + ks * 1024 + 512);
                const bf16x8 bfr = (bf16x8){vlo[0], vlo[1], vlo[2], vlo[3], vhi[0], vhi[1], vhi[2], vhi[3]};
                st[et] = __builtin_amdgcn_mfma_f32_32x32x16_bf16(af, bfr, st[et], 0, 0, 0); }
        }
    }
    RB_BAR();
}

__device__ __forceinline__ void out_item(int cgl, int h, const bf16* P, const unsigned char* RT, bf16* O, const float* lrf, const float* lrb, const float* gng, char* shm) {
    const int tid = threadIdx.x, lane = tid & 63, r32 = lane & 31, hi = lane >> 5; const int wid = __builtin_amdgcn_readfirstlane(tid >> 6);
    const long row0 = (long)cgl * 128; const unsigned lds0 = (unsigned)(uintptr_t)shm; const lds_cptr shm3 = (lds_cptr)shm;
    const float lgf = -__expf(lrf[h]) * LOG2E, lgb = -__expf(lrb[h]) * LOG2E;
    const int rb = wid & 3, dh = wid >> 2, c = 32 * rb + r32;
    dma_kimg(P, row0, KOFF + h * 128, lds0, wid, lane); dma_timg(P, row0, VOFF + h * 128, lds0 + 32768, wid, lane);
    dma_lin(RT + rt_off(0, cgl, h), lds0 + 65536, wid, lane); dma_lin(RT + rt_off(1, cgl, h), lds0 + 98304, wid, lane);
    bf16x8 qr[8];
    { const bf16* Qw = P + (row0 + c) * PP + QOFF + h * 128 + hi * 8;
#pragma unroll
      for (int s = 0; s < 8; ++s) qr[s] = *reinterpret_cast<const bf16x8*>(Qw + 16 * s); }
    RB_WAITV0_BAR();
    f32x16 o[2]; o[0] = f32x16{}; o[1] = f32x16{};
    const int troff = ((lane >> 4) & 1) * 32 + (lane & 3) * 8 + (4 * hi + ((lane & 15) >> 2)) * 64;
    const lds_cptr kp = shm3 + hi * 2048 + r32 * 16, vb = shm3 + 32768 + (2 * dh) * 8192 + troff;
#pragma unroll
    for (int kb = 0; kb < 4; ++kb) {
        f32x16 p = f32x16{};
#pragma unroll
        for (int s = 0; s < 8; ++s) { const bf16x8 kf = *(const __attribute__((address_space(3))) bf16x8*)(kp + s * 4096 + kb * 512); p = __builtin_amdgcn_mfma_f32_32x32x16_bf16(kf, qr[s], p, 0, 0, 0); }
#pragma unroll
        for (int r = 0; r < 16; ++r) { const int m = 32 * kb + crow(r, hi), df = c - m; p[r] *= exp2f(df >= 0 ? lgf * (float)df : lgb * (float)(-df)); }
        u32x4 pw0, pw1;
#pragma unroll
        for (int e = 0; e < 4; ++e) { pw0[e] = cvtpk_s(p[2 * e], p[2 * e + 1]); pw1[e] = cvtpk_s(p[8 + 2 * e], p[8 + 2 * e + 1]); }
#pragma unroll
        for (int d0 = 0; d0 < 2; ++d0) {
            { const s16x4 vlo = vtr(vb + d0 * 8192 + (2 * kb) * 1024), vhi = vtr(vb + d0 * 8192 + (2 * kb) * 1024 + 512);
              o[d0] = __builtin_amdgcn_mfma_f32_32x32x16_bf16(__builtin_bit_cast(bf16x8, pw0), (bf16x8){vlo[0], vlo[1], vlo[2], vlo[3], vhi[0], vhi[1], vhi[2], vhi[3]}, o[d0], 0, 0, 0); }
            { const s16x4 vlo = vtr(vb + d0 * 8192 + (2 * kb + 1) * 1024), vhi = vtr(vb + d0 * 8192 + (2 * kb + 1) * 1024 + 512);
              o[d0] = __builtin_amdgcn_mfma_f32_32x32x16_bf16(__builtin_bit_cast(bf16x8, pw1), (bf16x8){vlo[0], vlo[1], vlo[2], vlo[3], vhi[0], vhi[1], vhi[2], vhi[3]}, o[d0], 0, 0, 0); }
        }
    }
#pragma unroll
    for (int dir = 0; dir < 2; ++dir) {
        const float dec = dir ? exp2f(lgb * (float)(128 - c)) : exp2f(lgf * (float)(c + 1));
        const lds_cptr rp = shm3 + 65536 + dir * 32768 + hi * 2048 + (64 * dh + r32) * 16;
#pragma unroll
        for (int s = 0; s < 8; ++s) { const bf16x8 qs = scale8(qr[s], dec);
#pragma unroll
            for (int d0 = 0; d0 < 2; ++d0) { const bf16x8 rf = *(const __attribute__((address_space(3))) bf16x8*)(rp + s * 4096 + d0 * 512); o[d0] = __builtin_amdgcn_mfma_f32_32x32x16_bf16(qs, rf, o[d0], 0, 0, 0); } }
    }
    float ss[16];
#pragma unroll
    for (int r = 0; r < 16; ++r) { float v = o[0][r] * o[0][r] + o[1][r] * o[1][r]; v += __shfl_xor(v, 1); v += __shfl_xor(v, 2); v += __shfl_xor(v, 4); v += __shfl_xor(v, 8); v += __shfl_xor(v, 16); ss[r] = v; }
    float* part = (float*)(shm + 131072);
    if (r32 == 0) {
#pragma unroll
        for (int r = 0; r < 16; ++r) part[dh * 128 + 32 * rb + crow(r, hi)] = ss[r]; }
    RB_BAR();
    float* stg = (float*)(shm + wid * 8192);
    { const float g0 = gng[h * 128 + 64 * dh + r32], g1 = gng[h * 128 + 64 * dh + 32 + r32];
#pragma unroll
      for (int r = 0; r < 16; ++r) { const int orow = crow(r, hi); const float rs = rsqrtf((part[32 * rb + orow] + part[128 + 32 * rb + orow]) * (1.f / 128.f) + EPS);
          stg[orow * 64 + r32] = o[0][r] * rs * g0; stg[orow * 64 + 32 + r32] = o[1][r] * rs * g1; } }
    asm volatile("s_waitcnt lgkmcnt(0)" ::: "memory");
    { const bf16* Gw = P + (row0 + 32 * rb) * PP + GOFF + h * 128 + 64 * dh; bf16* Ow = O + (row0 + 32 * rb) * 1024 + h * 128 + 64 * dh;
#pragma unroll
      for (int i = 0; i < 4; ++i) { const int row = i * 8 + (lane >> 3), ch = lane & 7; const f32x4 a = *(const f32x4*)(stg + row * 64 + ch * 8), bq = *(const f32x4*)(stg + row * 64 + ch * 8 + 4);
          const u32x4 gt = *(const u32x4*)(Gw + (long)row * PP + ch * 8); u32x4 w;
          w[0] = cvtpk_s(a[0] * __uint_as_float(gt[0] << 16), a[1] * __uint_as_float(gt[0] & 0xffff0000u)); w[1] = cvtpk_s(a[2] * __uint_as_float(gt[1] << 16), a[3] * __uint_as_float(gt[1] & 0xffff0000u));
          w[2] = cvtpk_s(bq[0] * __uint_as_float(gt[2] << 16), bq[1] * __uint_as_float(gt[2] & 0xffff0000u)); w[3] = cvtpk_s(bq[2] * __uint_as_float(gt[3] << 16), bq[3] * __uint_as_float(gt[3] & 0xffff0000u));
          *(u32x4*)(Ow + (long)row * 1024 + ch * 8) = w; } }
    RB_BAR();
}
}
#define LAS __attribute__((address_space(3)))
constexpr int NWAVES = 8, NTHREADS = 512;
constexpr int RING_BYTES = 131072, LDS_BYTES = 147456;
#define LDS_WAIT() asm volatile("s_waitcnt lgkmcnt(0)" ::: "memory")

struct Args { const float* in[14]; float* out; unsigned char* ws; int ph_lo, ph_hi; };

__device__ __forceinline__ void p0_mod_item(const Args& a, LAS unsigned char* lds, int item) {
    const int tid = threadIdx.x, lane = tid & 63, wave = tid >> 6, col = tid & 31, kl = tid >> 5, n0 = item * 32;
    const float* cp = a.in[2]; const float* cs = a.in[3]; const float* W = a.in[5]; const float* bias = a.in[6]; float* mod = (float*)(a.ws + WS_MOD);
    LAS float* sl = (LAS float*)lds;
    LAS float* red = (LAS float*)(lds + 40960);
    float acc[NB];
#pragma unroll
    for (int b = 0; b < NB; ++b) acc[b] = 0.f;
    for (int kc = 0; kc < 4; ++kc) {
        __syncthreads();
        for (int e = tid; e < NB * 256; e += NTHREADS) { const int b = e >> 8, k = e & 255; const float* c = b < 4 ? cp + b * DM : cs + (b - 4) * DM; sl[e] = silu(c[kc * 256 + k]); }
        __syncthreads();
#pragma unroll 4
        for (int i = 0; i < 16; ++i) { const int k = kl + 16 * i; const float w = W[(size_t)(kc * 256 + k) * 3072 + n0 + col];
#pragma unroll
            for (int b = 0; b < NB; ++b) acc[b] += sl[b * 256 + k] * w; }
    }
#pragma unroll
    for (int b = 0; b < NB; ++b) acc[b] += __shfl_xor(acc[b], 32);
    __syncthreads();
    if (lane < 32) {
#pragma unroll
        for (int b = 0; b < NB; ++b) red[(wave * NB + b) * 32 + col] = acc[b]; }
    __syncthreads();
    for (int e = tid; e < NB * 32; e += NTHREADS) { const int b = e >> 5, c = e & 31; float s = 0.f;
        for (int w = 0; w < 8; ++w) s += red[(w * NB + b) * 32 + c];
        mod[b * 3072 + n0 + c] = s + bias[n0 + c]; }
    __syncthreads();
}
__device__ __forceinline__ void p0_transpose_item(const float* W, int K, int N, bf16* WT, bool perm, LAS float* scr, int item, int lane) {
    const int nblk = N / 32, kb = item / nblk, nb = item % nblk, k0 = 64 * kb, n0 = 32 * nb;
    const int p0 = perm ? ((n0 >> 8) * 256 + ((n0 >> 5) & 1) * 128 + ((n0 >> 6) & 3) * 32) : n0;
#pragma unroll 8
    for (int i = 0; i < 32; ++i) { const int kk = 2 * i + (lane >> 5); scr[kk * 33 + (lane & 31)] = W[(size_t)(k0 + kk) * N + n0 + (lane & 31)]; }
    LDS_WAIT(); asm volatile("" ::: "memory");
    const int c = lane & 7;
#pragma unroll
    for (int j = 0; j < 4; ++j) { const int n = (lane >> 3) + 8 * j; const LAS float* s = scr + (8 * c) * 33 + n;
        uint4 o; o.x = pk2(s[0 * 33], s[1 * 33]); o.y = pk2(s[2 * 33], s[3 * 33]); o.z = pk2(s[4 * 33], s[5 * 33]); o.w = pk2(s[6 * 33], s[7 * 33]);
        *(uint4*)(WT + (size_t)(p0 + n) * K + k0 + 8 * c) = o; }
    LDS_WAIT(); asm volatile("" ::: "memory");
}
__device__ __forceinline__ void p0_prologue(const Args& a, LAS unsigned char* lds) {
    const int tid = threadIdx.x, lane = tid & 63, wave = __builtin_amdgcn_readfirstlane(tid >> 6), G = gridDim.x;
    for (int it = blockIdx.x; it < 96; it += G) p0_mod_item(a, lds, it);
    __syncthreads();
    if ((int)blockIdx.x == G - 1) {
        float* tabR = (float*)(a.ws + WS_TAB); float* tabA = tabR + 4096;
        for (int e = tid; e < 2048; e += NTHREADS) { const int pos = e >> 5, i = e & 31; float sn, cs; sincosf((float)pos * powf(10000.f, -(float)i / 32.f), &sn, &cs); tabR[e] = cs; tabR[2048 + e] = sn; }
        for (int e = tid; e < 1024; e += NTHREADS) { const int pos = e >> 4, i = e & 15; float sn, cs; sincosf((float)pos * powf(10000.f, -(float)i / 16.f), &sn, &cs); tabA[e] = cs; tabA[1024 + e] = sn; }
    }
    LAS float* scr = (LAS float*)(lds + wave * 16384);
    const int gw = blockIdx.x * NWAVES + wave, NGW = G * NWAVES;
    constexpr int I_IN = (DM / 64) * (INC / 32), I_OUT = (DM / 64) * (DM / 32);
    for (int it = gw; it < I_IN + I_OUT; it += NGW) {
        if (it < I_IN) p0_transpose_item(a.in[7], DM, INC, (bf16*)(a.ws + WS_WIN), true, scr, it, lane);
        else p0_transpose_item(a.in[13], DM, DM, (bf16*)(a.ws + WS_WOUT), false, scr, it - I_IN, lane);
    }
}
__device__ __forceinline__ void p1_norm(const Args& a) {
    typedef float f4 __attribute__((ext_vector_type(4)));
    const int tid = threadIdx.x, lane = tid & 63, wave = tid >> 6; const int gw = blockIdx.x * NWAVES + wave, NGW = gridDim.x * NWAVES;
    const float* mod = (const float*)(a.ws + WS_MOD); bf16* H = (bf16*)(a.ws + WS_H);
    const int per = (M + NGW - 1) / NGW; int curb = -1; f4 gs[4], sh[4];
    for (int m = gw * per; m < M && m < (gw + 1) * per; ++m) {
        const int b = batch_of(m);
        if (b != curb) { curb = b;
#pragma unroll
            for (int j = 0; j < 4; ++j) { const f4 g = ((const f4*)a.in[4])[lane + 64 * j], sc = ((const f4*)(mod + b * 3072 + 1024))[lane + 64 * j]; gs[j] = g * (1.f + sc); sh[j] = ((const f4*)(mod + b * 3072))[lane + 64 * j]; } }
        const float* x = m < NTOK_P ? a.in[0] + (size_t)m * DM : a.in[1] + (size_t)(m - NTOK_P) * DM;
        f4 v[4]; float s = 0.f;
#pragma unroll
        for (int j = 0; j < 4; ++j) { v[j] = ((const f4*)x)[lane + 64 * j]; s += (v[j][0] * v[j][0] + v[j][1] * v[j][1]) + (v[j][2] * v[j][2] + v[j][3] * v[j][3]); }
#pragma unroll
        for (int o = 1; o < 64; o <<= 1) s += __shfl_xor(s, o);
        const float r = rsqrtf(s * (1.f / DM) + EPS);
        unsigned long long* o8 = (unsigned long long*)(H + (size_t)m * DM) + lane;
#pragma unroll
        for (int j = 0; j < 4; ++j) { const f4 y = v[j] * r * gs[j] + sh[j]; o8[64 * j] = (unsigned long long)pk2(y[0], y[1]) | ((unsigned long long)pk2(y[2], y[3]) << 32); }
    }
}
__device__ __forceinline__ void p3_scan(const Args& a, char* shm) {
    for (int it = blockIdx.x; it < 288; it += gridDim.x) {
        int b, h, dir;
        if (it < 32) { b = it >> 3; h = (it >> 1) & 3; dir = it & 1; } else { const int j = it - 32; b = 4 + (j >> 3); h = (j >> 1) & 3; dir = j & 1; }
        ret_body::scan_item(b, h, dir, (const bf16*)(a.ws + WS_PROJ), a.ws + WS_RT, a.in[8], a.in[9], shm);
    }
}
__device__ __forceinline__ void p4_retout(const Args& a, char* shm) {
    for (int it = blockIdx.x; it < 2560; it += gridDim.x)
        ret_body::out_item(it >> 2, it & 3, (const bf16*)(a.ws + WS_PROJ), a.ws + WS_RT, (bf16*)(a.ws + WS_MIX), a.in[8], a.in[9], a.in[10], shm);
}
__device__ __forceinline__ void p5_attn(const Args& a, char* shm) {
    const int G = gridDim.x; const attn_body::bf16* P = (const attn_body::bf16*)(a.ws + WS_PROJ); attn_body::bf16* O = (attn_body::bf16*)(a.ws + WS_MIX);
    if (G == 256) {
        const int x = blockIdx.x & 7, j = blockIdx.x >> 3;
        for (int i = 0; i < 10; ++i) {
            if (i < 2) { const int u = i * 32 + j, b = x >> 1, kvh = x & 1; attn_body::attn_unit<8>((long)b * 4096, 4096, kvh * 4 + (u & 3), u >> 2, P, O, shm); }
            else { const int gi = x * 8 + (i - 2), b = gi >> 1, kvh = gi & 1; attn_body::attn_unit<8>((long)NTOK_P + (long)b * 2048, 2048, kvh * 4 + (j & 3), j >> 2, P, O, shm); }
        }
    } else {
        for (int it = blockIdx.x; it < 2560; it += G) {
            if (it < 512) { const int b = it >> 7, h = (it >> 4) & 7, qb = it & 15; attn_body::attn_unit<8>((long)b * 4096, 4096, h, qb, P, O, shm); }
            else { const int j = it - 512, b = j >> 6, h = (j >> 3) & 7, qb = j & 7; attn_body::attn_unit<8>((long)NTOK_P + (long)b * 2048, 2048, h, qb, P, O, shm); }
        }
    }
}
__global__ void __launch_bounds__(NTHREADS, 2) mk_fwd(Args a) {
    extern __shared__ __attribute__((aligned(16))) unsigned char lds_raw[];
    LAS unsigned char* lds = (LAS unsigned char*)lds_raw;
    const int lo = a.ph_lo, hi = a.ph_hi;
#define IN(k) (lo <= (k) && (k) < hi)
#define SEAM(k) do { if (IN(k) && IN((k) + 1)) { cg::this_grid().sync(); } } while (0)
    if (IN(0)) { p0_prologue(a, lds); }
    SEAM(0);
    if (IN(1)) { p1_norm(a); }
    SEAM(1);
    if (IN(2)) {
        pg8::Gemm g{(const bf16*)(a.ws + WS_H), (const bf16*)(a.ws + WS_WIN), M, INC, DM}; pg8::StaticOrder S; S.init(M, INC, gridDim.x, (int)blockIdx.x);
        const float* tabR = (const float*)(a.ws + WS_TAB);
        pg8::EpiIn E{(bf16*)(a.ws + WS_PROJ), tabR, tabR + 4096, a.in[11], a.in[12]};
        pg8::gemm_phase<pg8::EpiIn, pg8::StaticOrder, true, true>(lds, g, S, E);
    }
    SEAM(2);
    if (IN(3)) { p3_scan(a, (char*)lds_raw); }
    SEAM(3);
    if (IN(4)) { p4_retout(a, (char*)lds_raw); }
    if (IN(5)) { p5_attn(a, (char*)lds_raw); }
    SEAM(5);
    if (IN(6)) {
        pg8::Gemm g{(const bf16*)(a.ws + WS_MIX), (const bf16*)(a.ws + WS_WOUT), M, DM, DM}; pg8::StaticOrder S; S.init(M, DM, gridDim.x, (int)blockIdx.x);
        pg8::EpiOut E{a.in[0], a.in[1], (const float*)(a.ws + WS_MOD), a.out};
        pg8::gemm_phase<pg8::EpiOut, pg8::StaticOrder, true, true>(lds, g, S, E);
    }
#undef IN
#undef SEAM
}
extern "C" void kernel_launch(void* const* d_in, const int* in_sizes, int n_in, void* d_out, int out_size, void* d_ws, size_t ws_size, hipStream_t stream) {
    static int grid = 0;
    if (grid == 0) {
        int dev = 0, cus = 0, per_cu = 0;
        hipGetDevice(&dev); hipDeviceGetAttribute(&cus, hipDeviceAttributeMultiprocessorCount, dev);
        hipFuncSetAttribute((const void*)mk_fwd, hipFuncAttributeMaxDynamicSharedMemorySize, LDS_BYTES);
        if (hipOccupancyMaxActiveBlocksPerMultiprocessor(&per_cu, (const void*)mk_fwd, NTHREADS, LDS_BYTES) != hipSuccess || per_cu < 1) {
            fprintf(stderr, "kernel_launch: occupancy query reports %d workgroups per CU; nothing launched\n", per_cu); grid = -1; }
        else grid = cus;
        (void)hipGetLastError();
        if (ws_size < WS_END || n_in != 14) { fprintf(stderr, "kernel_launch: workspace too small (%zu < %zu) or n_in %d != 14\n", ws_size, (size_t)WS_END, n_in); grid = -1; }
    }
    if (grid < 0) return;
    Args a{};
    for (int i = 0; i < 14; ++i) a.in[i] = (const float*)d_in[i];
    a.out = (float*)d_out; a.ws = (unsigned char*)d_ws; a.ph_lo = 0; a.ph_hi = 7;
    void* args[] = {&a};
    const hipError_t e = hipLaunchCooperativeKernel((const void*)mk_fwd, dim3(grid), dim3(NTHREADS), args, LDS_BYTES, stream);
    if (e != hipSuccess) fprintf(stderr, "kernel_launch: cooperative launch failed: %s (grid %d)\n", hipGetErrorString(e), grid);
}
```

```cpp
#include <hip/hip_runtime.h>
#include <cstdio>
#include <cstdint>

#define LAS __attribute__((address_space(3)))
#ifndef DYN_OUT
#define DYN_OUT 1
#endif
#define WT_STORES DYN_OUT
#ifndef NT_PROJ
#define NT_PROJ 0
#endif
#ifndef SC1_PROJ
#define SC1_PROJ 0
#endif
typedef unsigned short bf16;
constexpr int DM = 1024, NTOK_P = 4 * 4096, NTOK_S = 32 * 2048, M = NTOK_P + NTOK_S;
constexpr int NB = 36, INC = 3328;
constexpr float EPS = 1e-6f;
constexpr float C2 = 0.125f * 1.4426950408889634f;
constexpr float RK_SCALE = 0.08838834764831845f;
constexpr size_t MiB = 1u << 20;
constexpr size_t WS_CTL = 0, CTL_BYTES = 1 * MiB, CTL_ZERO_BYTES = 256 * 1024;
constexpr size_t WS_MOD = 1 * MiB;
constexpr size_t WS_TAB = 2 * MiB;
constexpr size_t WS_WIN = 4 * MiB;
constexpr size_t WS_WOUT = 12 * MiB;
constexpr size_t WS_H = 16 * MiB;
constexpr size_t WS_MIX = WS_H;
constexpr size_t WS_PROJ = 176 * MiB;
constexpr size_t WS_RT = 696 * MiB;
constexpr size_t WS_END = 856 * MiB;

__host__ __device__ __forceinline__ size_t PG_BASE(int g) { return g < 32 ? (size_t)(g >> 1) * M * 128 + (size_t)(g & 1) * 64 : (size_t)g * M * 64; }
__host__ __device__ __forceinline__ int PG_PITCH(int g) { return g < 32 ? 128 : 64; }
__device__ __forceinline__ unsigned f2bf(float f) { unsigned u = __builtin_bit_cast(unsigned, f); return (u + 0x7fffu + ((u >> 16) & 1u)) >> 16; }
__device__ __forceinline__ unsigned pk2(float lo, float hi) { return f2bf(lo) | (f2bf(hi) << 16); }
__device__ __forceinline__ float bf2f(unsigned short h) { return __builtin_bit_cast(float, (unsigned)h << 16); }
__device__ __forceinline__ float silu(float v) { return v * __builtin_amdgcn_rcpf(1.f + __builtin_amdgcn_exp2f(-1.4426950408889634f * v)); }
__device__ __forceinline__ int batch_of(int m) { return m < NTOK_P ? (m >> 12) : 4 + ((m - NTOK_P) >> 11); }
__device__ __forceinline__ int tpos_of(int m) { return m < NTOK_P ? (m & 4095) : (m & 2047); }
namespace pg8 {
#define PG8_LAS __attribute__((address_space(3)))
typedef unsigned short bf16_t;
typedef short bf16x8 __attribute__((ext_vector_type(8)));
typedef float f32x4 __attribute__((ext_vector_type(4)));
typedef unsigned u32x4 __attribute__((ext_vector_type(4)));
constexpr int BM = 256, BK = 64, HALF = 128, HTB = HALF * BK * 2  , STAGE_BYTES = 8 * HTB, NXCD = 8, WGM = 8;

__host__ __device__ __forceinline__ int lds_byte(int r, int c) { const int st = (r >> 4) * 2 + (c >> 5), rr = r & 15, cc = c & 31, ob = rr * 64 + cc * 2; return st * 1024 + (ob ^ (((ob >> 9) & 1) << 5)); }
__host__ __device__ __forceinline__ void stage_rc(int b, int& R, int& C) { const int st = b / 1024, sb = b % 1024, swz = sb ^ (((sb >> 9) & 1) << 5); R = (st >> 1) * 16 + swz / 64; C = (st & 1) * 32 + (swz % 64) / 2; }
__host__ __device__ __forceinline__ int perm32(int rho) { const int n = rho >> 4, i = rho & 15; return 8 * (i >> 2) + 4 * n + (i & 3); }

struct Unit { int pm, pn; };
struct Gemm { const bf16_t* A; const bf16_t* Bt; int M, N, K; };

struct StaticOrder {
    int nM, nN, nwg, G, c;
    __host__ __device__ void init(int M, int N, int G_, int c_) { nM = M / BM; nN = N / BM; nwg = nM * nN; G = G_; c = c_; }
    __host__ __device__ bool next(int i, Unit& u) const {
        const long L = (long)i * G + c; if (L >= nwg) return false;
        int wgid = (int)L; { const int q = nwg / NXCD, r = nwg % NXCD, xcd = wgid % NXCD, off = wgid / NXCD; wgid = (xcd < r ? xcd * (q + 1) : r * (q + 1) + (xcd - r) * q) + off; }
        const int nig = WGM * nN, gid = wgid / nig, fm = gid * WGM, gsz = (nM - fm) < WGM ? (nM - fm) : WGM;
        u.pm = fm + ((wgid % nig) % gsz); u.pn = (wgid % nig) / gsz; return true;
    }
    __device__ __forceinline__ void a_ready(const Unit&) const {}
    __device__ __forceinline__ void done(const Unit&) const {}
    __device__ __forceinline__ void between(const Unit&, const Unit&) const {}
};
__device__ __forceinline__ unsigned cvt_pk_bf16(float lo, float hi) { unsigned r; asm volatile("v_cvt_pk_bf16_f32 %0, %1, %2" : "=v"(r) : "v"(lo), "v"(hi)); return r; }
template <class Epi, class Sched, bool ALIGN_EPI = false, bool SP2 = false>
__device__ __forceinline__ void gemm_phase(PG8_LAS unsigned char* lds, const Gemm g, const Sched& S, const Epi& E) {
    const int tid = threadIdx.x, wid = __builtin_amdgcn_readfirstlane(tid >> 6), lane = tid & 63, wr = wid >> 2, wc = wid & 3, fr = lane & 15, fq = lane >> 4;
    const int K = g.K, nt = K / BK;
    unsigned voffA[2], voffB[2];
#pragma unroll
    for (int i = 0; i < 2; ++i) { int R, C; stage_rc(tid * 16 + i * 8192, R, C); const int Rb = Epi::PERM ? ((R & ~31) + perm32(R & 31)) : R;
        voffA[i] = (unsigned)(R * K + C) * 2u; voffB[i] = (unsigned)(Rb * K + C) * 2u; }
    const size_t kstep = (size_t)(BK * 2);
    const size_t hstep = (size_t)HALF * K * 2;
    const size_t tstep = 2 * hstep;
    const unsigned ldsw = (unsigned)wid * 1024u;
    const int aoff = lds_byte(wr * 64 + fr, fq * 8), boff = lds_byte(wc * 32 + fr, fq * 8);
#define PG8_SA(b, h) (((b) * 2 + (h)) * HTB)
#define PG8_SB(b, h) ((4 + (b) * 2 + (h)) * HTB)
#define PG8_STAGE(bufoff, gbase, voff) do { _Pragma("unroll") for (int _i = 0; _i < 2; ++_i) \
        __builtin_amdgcn_global_load_lds((const unsigned*)((const char*)(gbase) + (voff)[_i]), (PG8_LAS unsigned*)(lds + (bufoff) + ldsw + _i * 8192), 16, 0, 0); } while (0)
#define PG8_LDA(dst, b, h) do { _Pragma("unroll") for (int m = 0; m < 4; ++m) _Pragma("unroll") for (int k = 0; k < 2; ++k) dst[m][k] = *(const PG8_LAS bf16x8*)(lds + PG8_SA(b, h) + aoff + m * 2048 + k * 1024); } while (0)
#define PG8_LDB(dst, b, h) do { _Pragma("unroll") for (int n = 0; n < 2; ++n) _Pragma("unroll") for (int k = 0; k < 2; ++k) dst[n][k] = *(const PG8_LAS bf16x8*)(lds + PG8_SB(b, h) + boff + n * 2048 + k * 1024); } while (0)
#define PG8_MMA(ai, bj, At, Bt) do { __builtin_amdgcn_s_setprio(1); _Pragma("unroll") for (int m = 0; m < 4; ++m) _Pragma("unroll") for (int n = 0; n < 2; ++n) _Pragma("unroll") for (int k = 0; k < 2; ++k) \
        acc[ai][bj][m][n] = __builtin_amdgcn_mfma_f32_16x16x32_bf16(Bt[n][k], At[m][k], acc[ai][bj][m][n], 0, 0, 0); __builtin_amdgcn_s_setprio(0); } while (0)
#define PG8_WAIT_V(n) asm volatile("s_waitcnt vmcnt(" #n ")" ::: "memory")
#define PG8_WAIT_L(n) asm volatile("s_waitcnt lgkmcnt(" #n ")" ::: "memory")
#define PG8_BAR __builtin_amdgcn_s_barrier()
#define PG8_SCHED __builtin_amdgcn_sched_barrier(0)
    Unit cur, nxt; int ui = 0;
    if (!S.next(0, cur)) return;
    f32x4 acc[2][2][4][2];
#pragma unroll
    for (int a = 0; a < 2; ++a)
#pragma unroll
        for (int b = 0; b < 2; ++b)
#pragma unroll
            for (int m = 0; m < 4; ++m)
#pragma unroll
                for (int n = 0; n < 2; ++n) acc[a][b][m][n] = (f32x4){0.f, 0.f, 0.f, 0.f};
    bf16x8 At[4][2], B0[2][2], B1[2][2];
    const char* cA = (const char*)g.A + (size_t)cur.pm * tstep; const char* cB = (const char*)g.Bt + (size_t)cur.pn * tstep;
    S.a_ready(cur);
    if constexpr (SP2) {
        PG8_STAGE(PG8_SB(0, 0), cB, voffB); PG8_STAGE(PG8_SB(0, 1), cB + hstep, voffB); PG8_STAGE(PG8_SA(0, 0), cA, voffA); PG8_STAGE(PG8_SA(0, 1), cA + hstep, voffA);
        if (wr == 1) PG8_BAR;
        PG8_WAIT_V(2); PG8_BAR;
        PG8_STAGE(PG8_SB(1, 0), cB + kstep, voffB); PG8_STAGE(PG8_SA(1, 0), cA + kstep, voffA); PG8_STAGE(PG8_SB(1, 1), cB + hstep + kstep, voffB);
        PG8_WAIT_V(6); PG8_BAR;
    } else {
        PG8_STAGE(PG8_SB(0, 0), cB, voffB); PG8_STAGE(PG8_SA(0, 0), cA, voffA); PG8_STAGE(PG8_SB(0, 1), cB + hstep, voffB); PG8_STAGE(PG8_SA(0, 1), cA + hstep, voffA);
        if (wr == 1) PG8_BAR;
        PG8_WAIT_V(4); PG8_BAR;
        PG8_STAGE(PG8_SB(1, 0), cB + kstep, voffB); PG8_STAGE(PG8_SA(1, 0), cA + kstep, voffA); PG8_STAGE(PG8_SB(1, 1), cB + hstep + kstep, voffB);
        PG8_WAIT_V(6); PG8_BAR;
    }
    for (;;) {
        const bool has_next = S.next(ui + 1, nxt);
        const char* nA = has_next ? (const char*)g.A + (size_t)nxt.pm * tstep : cA; const char* nB = has_next ? (const char*)g.Bt + (size_t)nxt.pn * tstep : cB;
        if constexpr (Epi::PREFETCH) E.prefetch(cur, lds, wid, lane);
#ifdef GEMM_LOOP_ALIGN
        asm volatile(GEMM_LOOP_ALIGN ::: "memory");
#endif
        for (int t = 0; t < nt; t += 2) {
            const bool last = (t == nt - 2);
            const char* a1 = cA + (size_t)(t + 1) * kstep;
            const char* a2 = last ? nA : cA + (size_t)(t + 2) * kstep; const char* b2 = last ? nB : cB + (size_t)(t + 2) * kstep;
            const char* a3 = a2 + kstep; const char* b3 = b2 + kstep;
            if (last && has_next) S.a_ready(nxt);
            if constexpr (SP2) {
            PG8_LDB(B0, 0, 0); PG8_LDB(B1, 0, 1); PG8_SCHED; PG8_LDA(At, 0, 0); PG8_STAGE(PG8_SA(1, 1), a1 + hstep, voffA);
            PG8_WAIT_V(8); PG8_WAIT_L(0); PG8_BAR; PG8_MMA(0, 0, At, B0); PG8_MMA(0, 1, At, B1); PG8_BAR; PG8_SCHED;
            PG8_LDA(At, 0, 1); PG8_STAGE(PG8_SB(0, 0), b2, voffB); PG8_STAGE(PG8_SB(0, 1), b2 + hstep, voffB); PG8_STAGE(PG8_SA(0, 0), a2, voffA);
            PG8_WAIT_V(8); PG8_WAIT_L(0); PG8_BAR; PG8_MMA(1, 0, At, B0); PG8_MMA(1, 1, At, B1); PG8_BAR; PG8_SCHED;
            PG8_LDB(B0, 1, 0); PG8_LDB(B1, 1, 1); PG8_SCHED; PG8_LDA(At, 1, 0); PG8_STAGE(PG8_SA(0, 1), a2 + hstep, voffA);
            PG8_WAIT_V(8); PG8_WAIT_L(0); PG8_BAR; PG8_MMA(0, 0, At, B0); PG8_MMA(0, 1, At, B1); PG8_BAR; PG8_SCHED;
            PG8_LDA(At, 1, 1); PG8_STAGE(PG8_SB(1, 0), b3, voffB); PG8_STAGE(PG8_SB(1, 1), b3 + hstep, voffB); PG8_STAGE(PG8_SA(1, 0), a3, voffA);
            PG8_WAIT_V(8); PG8_WAIT_L(0); PG8_BAR; PG8_MMA(1, 0, At, B0); PG8_MMA(1, 1, At, B1); PG8_BAR; PG8_SCHED;
            } else {
            PG8_LDB(B0, 0, 0); PG8_SCHED; PG8_LDA(At, 0, 0); PG8_STAGE(PG8_SA(1, 1), a1 + hstep, voffA);
            PG8_WAIT_L(8); PG8_BAR; PG8_WAIT_L(0); PG8_MMA(0, 0, At, B0); PG8_BAR; PG8_SCHED;
            PG8_LDB(B1, 0, 1); PG8_STAGE(PG8_SB(0, 0), b2, voffB);
            PG8_BAR; PG8_WAIT_L(0); PG8_MMA(0, 1, At, B1); PG8_BAR;
            PG8_LDA(At, 0, 1); PG8_STAGE(PG8_SA(0, 0), a2, voffA);
            PG8_BAR; PG8_WAIT_L(0); PG8_MMA(1, 0, At, B0); PG8_BAR; PG8_SCHED;
            PG8_STAGE(PG8_SB(0, 1), b2 + hstep, voffB);
            PG8_WAIT_V(6); PG8_BAR; PG8_MMA(1, 1, At, B1); PG8_BAR;
            PG8_LDB(B0, 1, 0); PG8_SCHED; PG8_LDA(At, 1, 0); PG8_STAGE(PG8_SA(0, 1), a2 + hstep, voffA);
            PG8_WAIT_L(8); PG8_BAR; PG8_WAIT_L(0); PG8_MMA(0, 0, At, B0); PG8_BAR; PG8_SCHED;
            PG8_LDB(B1, 1, 1); PG8_STAGE(PG8_SB(1, 0), b3, voffB);
            PG8_BAR; PG8_WAIT_L(0); PG8_MMA(0, 1, At, B1); PG8_BAR;
            PG8_LDA(At, 1, 1); PG8_STAGE(PG8_SA(1, 0), a3, voffA);
            PG8_BAR; PG8_WAIT_L(0); PG8_MMA(1, 0, At, B0); PG8_BAR; PG8_SCHED;
            PG8_STAGE(PG8_SB(1, 1), b3 + hstep, voffB);
            PG8_WAIT_V(6); PG8_BAR; PG8_MMA(1, 1, At, B1); PG8_BAR;
            }
        }
        if constexpr (ALIGN_EPI) { if (wr == 0) PG8_BAR; }
        if constexpr (!Epi::AFTER_DRAIN) { E(acc, cur, wr, wc, fr, fq); S.done(cur); }
        if constexpr (ALIGN_EPI) { if (has_next) S.between(cur, nxt); }
        if (!has_next) break;
#pragma unroll
        for (int a = 0; a < 2; ++a)
#pragma unroll
            for (int b = 0; b < 2; ++b)
#pragma unroll
                for (int m = 0; m < 4; ++m)
#pragma unroll
                    for (int n = 0; n < 2; ++n) acc[a][b][m][n] = (f32x4){0.f, 0.f, 0.f, 0.f};
        cur = nxt; cA = nA; cB = nB; ++ui;
        if constexpr (ALIGN_EPI) { if (wr == 1) PG8_BAR; }
    }
    PG8_WAIT_V(0);
    if constexpr (!ALIGN_EPI) { if (wr == 0) PG8_BAR; }
    PG8_BAR;
    if constexpr (Epi::AFTER_DRAIN) { E.fused(acc, cur, wr, wc, fr, fq, lds, wid, lane); S.done(cur); }
#undef PG8_SA
#undef PG8_SB
#undef PG8_STAGE
#undef PG8_LDA
#undef PG8_LDB
#undef PG8_MMA
#undef PG8_WAIT_V
#undef PG8_WAIT_L
#undef PG8_BAR
#undef PG8_SCHED
}
}
namespace pg8 {
typedef unsigned u32x2 __attribute__((ext_vector_type(2)));
__device__ __forceinline__ f32x4 silu4(f32x4 v) { f32x4 o; o[0] = silu(v[0]); o[1] = silu(v[1]); o[2] = silu(v[2]); o[3] = silu(v[3]); return o; }
__host__ __device__ __forceinline__ bool in_is_att(int g) { return g >= 32 && g < 42; }
__host__ __device__ __forceinline__ int in_physrow(int Lc) {
    const int g = Lc >> 6, d = Lc & 63; int bj, fq; const int n = (d >> 2) & 1, j = d & 3;
    if (in_is_att(g)) { bj = (d >> 4) & 1; fq = 2 * (d >> 5) + ((d >> 3) & 1); } else { bj = d >> 5; fq = (d >> 3) & 3; }
    return (Lc >> 8) * 256 + 128 * bj + 32 * (g & 3) + 16 * n + 4 * fq + j;
}
struct EpiIn {
    static constexpr bool PERM = false, AFTER_DRAIN = false, PREFETCH = false;
    bf16_t* P; const PG8_LAS float* tabR; const PG8_LAS float* tabA; const float* qng; const float* kng;
    __device__ __forceinline__ static void st16(bf16_t* p, const f32x4& a, const f32x4& b) { u32x4 w; w.x = cvt_pk_bf16(a[0], a[1]); w.y = cvt_pk_bf16(a[2], a[3]); w.z = cvt_pk_bf16(b[0], b[1]); w.w = cvt_pk_bf16(b[2], b[3]);
#if SC1_PROJ
        asm volatile("global_store_dwordx4 %0, %1, off sc1\n\ts_nop 1" :: "v"(p), "v"(w) : "memory");
#elif NT_PROJ
        __builtin_nontemporal_store(w, (u32x4*)p);
#else
        *(u32x4*)p = w;
#endif
    }
    __device__ __forceinline__ void operator()(const f32x4 (&acc)[2][2][4][2], const Unit& u, int wr, int wc, int fr, int fq) const {
        const int g = u.pn * 4 + wc; const size_t gbase = PG_BASE(g); const int gpitch = PG_PITCH(g);
        const int rowb = u.pm * BM + wr * 64 + fr, tb = tpos_of(u.pm * BM);
        const bool img = g < 32, tsty = g >= 16 && g < 24; const size_t ibase = (size_t)(g >> 1) * M * 128 + (tsty ? (size_t)(2 * (g & 1)) * 4096 + 8 * fq : (size_t)(8 * (g & 1) + fq) * 1024);
        if (g < 16) {
            const float sc = (g >= 8) ? RK_SCALE : 1.f;
#define EPI_ROPE_ROW(ai, m) do { const int row_ = rowb + (ai) * HALF + (m) * 16; bf16_t* out = img ? P + ibase + (size_t)(row_ >> 7) * 16384 + (row_ & 127) * 8 : P + gbase + (size_t)row_ * gpitch + 8 * fq; f32x4 y[2][2]; \
                _Pragma("unroll") for (int n = 0; n < 2; ++n) { const f32x4 x1 = acc[ai][0][m][n], x2 = acc[ai][1][m][n]; y[0][n] = (x1 * c[n] - x2 * sn[n]) * sc; y[1][n] = (x2 * c[n] + x1 * sn[n]) * sc; } \
                st16(out, y[0][0], y[0][1]); st16(out + (img ? 4096 : 32), y[1][0], y[1][1]); } while (0)
#define EPI_ROPE_TAB(pos) f32x4 c[2], sn[2]; _Pragma("unroll") for (int n = 0; n < 2; ++n) { c[n] = *(const PG8_LAS f32x4*)(tabR + (pos) * 32 + 8 * fq + 4 * n); sn[n] = *(const PG8_LAS f32x4*)(tabR + 2048 + (pos) * 32 + 8 * fq + 4 * n); }
            if (g & 1) {
#pragma unroll
                for (int m = 0; m < 4; ++m) { EPI_ROPE_TAB(16 * m + fr)
#pragma unroll
                    for (int ai = 0; ai < 2; ++ai) EPI_ROPE_ROW(ai, m); }
            } else {
#pragma unroll
                for (int ai = 0; ai < 2; ++ai) { EPI_ROPE_TAB((tb >> 6) + 2 * ai + wr)
#pragma unroll
                    for (int m = 0; m < 4; ++m) EPI_ROPE_ROW(ai, m); }
            }
#undef EPI_ROPE_ROW
#undef EPI_ROPE_TAB
        } else if (in_is_att(g)) {
            const int H = fq >> 1, F = fq & 1; const float* gw = (g < 40) ? qng : kng; const float sc = (g < 40) ? C2 : 1.f;
            f32x4 w[2][2];
#pragma unroll
            for (int bj = 0; bj < 2; ++bj)
#pragma unroll
                for (int n = 0; n < 2; ++n) w[bj][n] = *(const f32x4*)(gw + 32 * H + 8 * F + 16 * bj + 4 * n);
#pragma unroll
            for (int ai = 0; ai < 2; ++ai)
#pragma unroll
                for (int m = 0; m < 4; ++m) {
                    const int pos = H ? (16 * m + fr) : ((tb >> 6) + 2 * ai + wr);
                    float ss = 0.f;
#pragma unroll
                    for (int bj = 0; bj < 2; ++bj)
#pragma unroll
                        for (int n = 0; n < 2; ++n) { const f32x4 x = acc[ai][bj][m][n]; ss += (x[0] * x[0] + x[1] * x[1]) + (x[2] * x[2] + x[3] * x[3]); }
                    ss += __shfl_xor(ss, 16); ss += __shfl_xor(ss, 32);
                    const float rn = rsqrtf(ss * (1.f / 64.f) + EPS);
                    const int row_ = rowb + ai * HALF + m * 16;
                    bf16_t* out = g >= 40 ? P + gbase + (size_t)(row_ >> 6) * 4096 + (4 * H + F) * 512 + (row_ & 63) * 8 : P + gbase + (size_t)row_ * gpitch + 32 * H + 8 * F;
                    f32x4 y[2][2];
#pragma unroll
                    for (int n = 0; n < 2; ++n) { const f32x4 c = *(const PG8_LAS f32x4*)(tabA + pos * 16 + 8 * F + 4 * n), sn = *(const PG8_LAS f32x4*)(tabA + 1024 + pos * 16 + 8 * F + 4 * n);
                        const f32x4 x1 = acc[ai][0][m][n] * rn * w[0][n], x2 = acc[ai][1][m][n] * rn * w[1][n]; y[0][n] = (x1 * c - x2 * sn) * sc; y[1][n] = (x2 * c + x1 * sn) * sc; }
                    st16(out, y[0][0], y[0][1]); st16(out + (g >= 40 ? 1024 : 16), y[1][0], y[1][1]); }
        } else {
            const bool act = (g >= 24 && g < 32) || g >= 44;
#pragma unroll
            for (int ai = 0; ai < 2; ++ai)
#pragma unroll
                for (int m = 0; m < 4; ++m) { const int row_ = rowb + ai * HALF + m * 16; const bool av = g == 42 || g == 43;
                    bf16_t* out = img ? P + ibase + (size_t)(row_ >> 7) * 16384 + (tsty ? ((row_ & 127) >> 4) * 512 + (row_ & 15) * 32 : (row_ & 127) * 8) : av ? P + gbase + (size_t)(row_ >> 6) * 4096 + (row_ & 63) * 32 + 8 * fq : P + gbase + (size_t)row_ * gpitch + 8 * fq;
#pragma unroll
                    for (int bj = 0; bj < 2; ++bj) { f32x4 a0 = acc[ai][bj][m][0], a1 = acc[ai][bj][m][1]; if (act) { a0 = silu4(a0); a1 = silu4(a1); } st16(out + (img ? 4096 : av ? 2048 : 32) * bj, a0, a1); } }
        }
    }
};
struct EpiPlain {
    static constexpr bool PERM = false, AFTER_DRAIN = false, PREFETCH = false;
    bf16_t* P; int mode;
    __device__ __forceinline__ void operator()(const f32x4 (&acc)[2][2][4][2], const Unit& u, int wr, int wc, int fr, int fq) const {
        const int g = u.pn * 4 + wc; const size_t gbase = PG_BASE(g); const int gpitch = PG_PITCH(g); const int rowb = u.pm * BM + wr * 64 + fr;
#pragma unroll
        for (int ai = 0; ai < 2; ++ai)
#pragma unroll
            for (int m = 0; m < 4; ++m) { bf16_t* out = P + gbase + (size_t)(rowb + ai * HALF + m * 16) * gpitch + 8 * fq;
#pragma unroll
                for (int bj = 0; bj < 2; ++bj) { if (mode == 0) EpiIn::st16(out + 32 * bj, acc[ai][bj][m][0], acc[ai][bj][m][1]); else asm volatile("" :: "v"(acc[ai][bj][m][0]), "v"(acc[ai][bj][m][1])); } }
    }
};
#ifndef EPIOUT_NT
#define EPIOUT_NT 0
#endif
#if EPIOUT_NT
#define EPIOUT_LD(p) __builtin_nontemporal_load(p)
#define EPIOUT_ST(v, p) __builtin_nontemporal_store(v, p)
#else
#define EPIOUT_LD(p) (*(p))
#define EPIOUT_ST(v, p) (*(p) = (v))
#endif
struct EpiOut {
    static constexpr bool PERM = false, AFTER_DRAIN = false;
#ifndef X_PREFETCH
    static constexpr bool PREFETCH = false;
#else
    static constexpr bool PREFETCH = true;
#endif
    const float* xp; const float* xs; const float* mod; float* y;
    __device__ __forceinline__ void prefetch(const Unit& u, PG8_LAS unsigned char* lds, int wid, int lane) const {
        const int row0 = u.pm * BM; const float* xb = (row0 < NTOK_P ? xp + (size_t)row0 * DM : xs + (size_t)(row0 - NTOK_P) * DM) + u.pn * BM;
#pragma unroll
        for (int i = 0; i < 4; ++i) { const int L = (wid * 4 + i) * 64 + lane;
            __builtin_amdgcn_global_load_lds((const unsigned*)(xb + (size_t)(L >> 3) * DM + (L & 7) * 32), (PG8_LAS unsigned*)(lds + 131072 + 4096 + wid * 256), 4, 0, 0); }
    }
    __device__ __forceinline__ void operator()(const f32x4 (&acc)[2][2][4][2], const Unit& u, int wr, int wc, int fr, int fq) const {
        const int row0 = u.pm * BM, b = batch_of(row0); const float* __restrict__ gate = mod + b * 3072 + 2048;
        const float* __restrict__ xb = (row0 < NTOK_P ? xp + (size_t)row0 * DM : xs + (size_t)(row0 - NTOK_P) * DM) + u.pn * BM + wc * 32 + 4 * fq;
        float* __restrict__ yb = y + (size_t)row0 * DM + u.pn * BM + wc * 32 + 4 * fq;
        f32x4 gv[2][2];
#pragma unroll
        for (int bj = 0; bj < 2; ++bj)
#pragma unroll
            for (int n = 0; n < 2; ++n) gv[bj][n] = *(const f32x4*)(gate + u.pn * BM + bj * HALF + wc * 32 + 16 * n + 4 * fq);
#define EPO_ADDR(ai, m, bj, n) ((size_t)((ai) * HALF + wr * 64 + (m) * 16 + fr) * DM + (bj) * HALF + 16 * (n))
        f32x4 x0[4][2][2], x1[4][2][2];
#pragma unroll
        for (int m = 0; m < 4; ++m)
#pragma unroll
            for (int bj = 0; bj < 2; ++bj)
#pragma unroll
                for (int n = 0; n < 2; ++n) x0[m][bj][n] = EPIOUT_LD((const f32x4*)(xb + EPO_ADDR(0, m, bj, n)));
        __builtin_amdgcn_sched_barrier(0);
#pragma unroll
        for (int m = 0; m < 4; ++m)
#pragma unroll
            for (int bj = 0; bj < 2; ++bj)
#pragma unroll
                for (int n = 0; n < 2; ++n) x0[m][bj][n] = x0[m][bj][n] + gv[bj][n] * acc[0][bj][m][n];
        __builtin_amdgcn_sched_barrier(0);
#pragma unroll
        for (int m = 0; m < 4; ++m)
#pragma unroll
            for (int bj = 0; bj < 2; ++bj)
#pragma unroll
                for (int n = 0; n < 2; ++n) x1[m][bj][n] = EPIOUT_LD((const f32x4*)(xb + EPO_ADDR(1, m, bj, n)));
        __builtin_amdgcn_sched_barrier(0);
#pragma unroll
        for (int m = 0; m < 4; ++m)
#pragma unroll
            for (int bj = 0; bj < 2; ++bj)
#pragma unroll
                for (int n = 0; n < 2; ++n) EPIOUT_ST(x0[m][bj][n], (f32x4*)(yb + EPO_ADDR(0, m, bj, n)));
        __builtin_amdgcn_sched_barrier(0);
#pragma unroll
        for (int m = 0; m < 4; ++m)
#pragma unroll
            for (int bj = 0; bj < 2; ++bj)
#pragma unroll
                for (int n = 0; n < 2; ++n) EPIOUT_ST(x1[m][bj][n] + gv[bj][n] * acc[1][bj][m][n], (f32x4*)(yb + EPO_ADDR(1, m, bj, n)));
#undef EPO_ADDR
    }
};
}
#include <hip/hip_bf16.h>
#include <cmath>
namespace attn_body {
using bf16=__hip_bfloat16;
using bf16x8=__attribute__((ext_vector_type(8)))short;
using s16x4=__attribute__((ext_vector_type(4)))short;
using f32x16=__attribute__((ext_vector_type(16)))float;
using u32x4=__attribute__((ext_vector_type(4)))unsigned;
constexpr int D=64,DM=64,OPITCH=1024; constexpr long GSZ=(long)81920*64;
constexpr int NW=8,QBLK=32,QB=QBLK*NW,KVBLK=64;
constexpr int ATTN_PITCH=DM, ATTN_UNIT_ROWS=QB;
__device__ __forceinline__ int crow(int r,int hi){return (r&3)+8*(r>>2)+4*hi;}
#define SBAR() __builtin_amdgcn_sched_barrier(0)
__device__ __forceinline__ void cmask(f32x16&p0,f32x16&p1,int jb,int qrel,int hi){
  const float NEG=-INFINITY; int kb=64*jb+4*hi;
  #pragma unroll
  for(int r=0;r<16;++r){int kv=kb+(r&3)+8*(r>>2); if(kv>qrel)p0[r]=NEG; if(kv+32>qrel)p1[r]=NEG;}
}

constexpr int NSLOT=3, SLOTB=8192;
constexpr int LDS_K=0, LDS_V=NSLOT*SLOTB, LDS_WS=2*NSLOT*SLOTB, LDS_OST=LDS_WS+NW*64*4, LDS_GATE=LDS_OST+NW*4096, LDS_BYTES=LDS_GATE+NW*4096;
constexpr float C2=0.125f*1.4426950408889634f;
__device__ __forceinline__ void glds16(const void*gsrc,unsigned lds_dst){unsigned keep;
  asm volatile("s_mov_b32 %0, m0\n\ts_mov_b32 m0, %2\n\ts_nop 0\n\tglobal_load_lds_dwordx4 %1, off\n\ts_mov_b32 m0, %0":"=&s"(keep):"v"(gsrc),"s"(lds_dst):"memory");}
__device__ __forceinline__ float max3f(float a,float b,float c){float r;asm("v_max3_f32 %0, %1, %2, %3":"=v"(r):"v"(a),"v"(b),"v"(c));return r;}
__device__ __forceinline__ float max2f(float a,float b){float r;asm("v_max_f32_e32 %0, %1, %2":"=v"(r):"v"(a),"v"(b));return r;}
__device__ __forceinline__ float fadd_s(float a,float b){float r;asm("v_add_f32_e32 %0, %1, %2":"=v"(r):"v"(a),"v"(b));return r;}
__device__ __forceinline__ float fsub_s(float a,float b){float r;asm("v_sub_f32_e32 %0, %1, %2":"=v"(r):"v"(a),"v"(b));return r;}
typedef float f32x2_t __attribute__((ext_vector_type(2))); typedef __bf16 bf16x2_t __attribute__((ext_vector_type(2)));
__device__ __forceinline__ unsigned cvtpk_s(float lo,float hi){f32x2_t v={lo,hi};bf16x2_t b=__builtin_convertvector(v,bf16x2_t);return __builtin_bit_cast(unsigned,b);}
#define WAIT_BAR(N) asm volatile("s_waitcnt vmcnt(" #N ") lgkmcnt(0)\n\ts_barrier":::"memory")

__device__ __forceinline__ void qkt(f32x16&p0,f32x16&p1,const char*Kslot,const bf16x8*qr,const f32x16&negm,int r32,int hi){
  const char*kb=Kslot+hi*1024+r32*16;
  #pragma unroll
  for(int d0=0;d0<4;++d0){
    const bf16x8 b0=*reinterpret_cast<const bf16x8*>(kb+d0*2048);
    const bf16x8 b1=*reinterpret_cast<const bf16x8*>(kb+d0*2048+512);
    if(d0==0){p0=__builtin_amdgcn_mfma_f32_32x32x16_bf16(b0,qr[0],negm,0,0,0);p1=__builtin_amdgcn_mfma_f32_32x32x16_bf16(b1,qr[0],negm,0,0,0);}
    else{p0=__builtin_amdgcn_mfma_f32_32x32x16_bf16(b0,qr[d0],p0,0,0,0);p1=__builtin_amdgcn_mfma_f32_32x32x16_bf16(b1,qr[d0],p1,0,0,0);}}
}
typedef __attribute__((address_space(3))) const char* lds_cptr;
typedef short v4i16_t __attribute__((ext_vector_type(4)));
__device__ __forceinline__ void kload8(bf16x8*kf,lds_cptr kp){
  kf[0]=*(const __attribute__((address_space(3))) bf16x8*)(kp);      kf[1]=*(const __attribute__((address_space(3))) bf16x8*)(kp+512);
  kf[2]=*(const __attribute__((address_space(3))) bf16x8*)(kp+2048); kf[3]=*(const __attribute__((address_space(3))) bf16x8*)(kp+2560);
  kf[4]=*(const __attribute__((address_space(3))) bf16x8*)(kp+4096); kf[5]=*(const __attribute__((address_space(3))) bf16x8*)(kp+4608);
  kf[6]=*(const __attribute__((address_space(3))) bf16x8*)(kp+6144); kf[7]=*(const __attribute__((address_space(3))) bf16x8*)(kp+6656);
}
__device__ __forceinline__ void kload2(bf16x8*kf,lds_cptr kp,int j){ kf[2*j]=*(const __attribute__((address_space(3))) bf16x8*)(kp+j*2048); kf[2*j+1]=*(const __attribute__((address_space(3))) bf16x8*)(kp+j*2048+512); }
__device__ __forceinline__ s16x4 vtr(lds_cptr p){ return __builtin_bit_cast(s16x4,__builtin_amdgcn_ds_read_tr16_b64_v4i16((__attribute__((address_space(3))) v4i16_t*)p)); }
__device__ __forceinline__ float rowmax(const f32x16&p0,const f32x16&p1){
  float a=max3f(p0[0],p0[1],p1[0]),b=max3f(p0[2],p0[3],p1[1]);a=max3f(a,p1[2],p1[3]);
  #pragma unroll
  for(int r=4;r<16;r+=4){a=max3f(a,p0[r],p0[r+1]);b=max3f(b,p0[r+2],p0[r+3]);a=max3f(a,p1[r],p1[r+1]);b=max3f(b,p1[r+2],p1[r+3]);}
  const float m=max2f(a,b);
  auto rr=__builtin_amdgcn_permlane32_swap(__float_as_uint(m),__float_as_uint(m),false,false);
  return max2f(__uint_as_float(rr[0]),__uint_as_float(rr[1]));
}
__device__ __forceinline__ void pv(f32x16*o,int vb,bf16x8 pa0,bf16x8 pa1,bf16x8 pa2,bf16x8 pa3){
  #pragma unroll
  for(int d0=0;d0<2;++d0){s16x4 lo[4],hi[4];
    #pragma unroll
    for(int ks=0;ks<4;++ks){
      asm volatile("ds_read_b64_tr_b16 %0,%1 offset:%c2":"=&v"(lo[ks]):"v"(vb),"i"(d0*4096+ks*1024):"memory");
      asm volatile("ds_read_b64_tr_b16 %0,%1 offset:%c2":"=&v"(hi[ks]):"v"(vb),"i"(d0*4096+ks*1024+512):"memory");}
    asm volatile("s_waitcnt lgkmcnt(0)":::"memory");SBAR();
    #define PK(k) (bf16x8){lo[k][0],lo[k][1],lo[k][2],lo[k][3],hi[k][0],hi[k][1],hi[k][2],hi[k][3]}
    o[d0]=__builtin_amdgcn_mfma_f32_32x32x16_bf16(pa0,PK(0),o[d0],0,0,0);
    o[d0]=__builtin_amdgcn_mfma_f32_32x32x16_bf16(pa1,PK(1),o[d0],0,0,0);
    o[d0]=__builtin_amdgcn_mfma_f32_32x32x16_bf16(pa2,PK(2),o[d0],0,0,0);
    o[d0]=__builtin_amdgcn_mfma_f32_32x32x16_bf16(pa3,PK(3),o[d0],0,0,0);
    #undef PK
  }
}

__device__ __forceinline__ void store16_sc1(void*p,u32x4 v){ asm volatile("global_store_dwordx4 %0, %1, off sc1\n\ts_nop 1"::"v"(p),"v"(v):"memory"); }
#ifndef ATTN_STORE16
#if WT_STORES
#define ATTN_STORE16(p,v) store16_sc1((void*)(p),(v))
#else
#define ATTN_STORE16(p,v) (*(u32x4*)(p)=(v))
#endif
#endif
#ifndef ATTN_STORE16_X
#define ATTN_STORE16_X(p,v) (*(u32x4*)(p)=(v))
#endif
template<int THRL> __device__ __forceinline__ void attn_unit(long rowbase,int S,int h,int qb,int t0,const bf16*__restrict__ P,bf16*O,char*shm){
  int tid=threadIdx.x; asm volatile("":"+v"(tid));
  const int lane=tid&63,r32=lane&31,hi=lane>>5; const int wid=__builtin_amdgcn_readfirstlane(tid>>6);
  const int q0=qb*QB;
  const bf16*Qw=P+(32+h)*GSZ+(rowbase+q0+wid*QBLK)*DM;
  const bf16*Kh=P+(40+(h>>2))*GSZ+rowbase*DM,*Vh=P+(42+(h>>2))*GSZ+rowbase*DM;
  const unsigned lds0=(unsigned)(uintptr_t)shm;
  float*wsf=(float*)(shm+LDS_WS)+wid*64;
  const bf16*ksrc=Kh+wid*512+lane*8;
  const bf16*vsrc=Vh+wid*512+lane*8;
  const unsigned kdst=lds0+LDS_K+wid*1024, vdst=lds0+LDS_V+wid*1024;
  #define DMA_K(t,slot) glds16(ksrc+(long)(((t)+t0)&(NT-1))*KVBLK*DM,(unsigned)__builtin_amdgcn_readfirstlane(kdst+(slot)))
  #define DMA_V(t,slot) glds16(vsrc+(long)(((t)+t0)&(NT-1))*KVBLK*DM,(unsigned)__builtin_amdgcn_readfirstlane(vdst+(slot)))
  const int vb0=(int)(lds0+LDS_V)+((lane>>4)&1)*32+(lane&3)*8+(4*hi+((lane&15)>>2))*64;
  const char*Kbase=shm+LDS_K; bf16x8 kf[8];
  const lds_cptr shm3=(lds_cptr)shm; const lds_cptr kp0=shm3+LDS_K+hi*1024+r32*16; const lds_cptr vp0=shm3+LDS_V+((lane>>4)&1)*32+(lane&3)*8+(4*hi+((lane&15)>>2))*64;
  const int NT=S/KVBLK;
  { const bf16*Gw_=P+(44+h)*GSZ+(rowbase+q0+wid*QBLK)*DM+lane*8;
    _Pragma("unroll") for(int i=0;i<4;++i) glds16(Gw_+i*512,(unsigned)__builtin_amdgcn_readfirstlane(lds0+LDS_GATE+wid*4096+i*1024)); }
  DMA_K(0,0);DMA_V(0,0);DMA_K(1,SLOTB);
  bf16x8 qr[4];
  #pragma unroll
  for(int d0=0;d0<4;++d0)qr[d0]=*reinterpret_cast<const bf16x8*>(&Qw[(long)r32*DM+d0*16+hi*8]);
  float mhat=0.f,l_reg=0.f;f32x16 o[2];o[0]=f32x16{};o[1]=f32x16{};f32x16 negm=f32x16{};asm volatile("":"+v"(negm));
  #define CMASK(P0,P1,t) do{}while(0)
  bool resc=false;
  #define START(P0,P1) do{ const float rm=rowmax(P0,P1); resc=false; \
    { const float dl=rm; mhat=fadd_s(mhat,dl); \
      _Pragma("unroll") for(int r=0;r<16;++r){P0[r]=fsub_s(P0[r],dl);P1[r]=fsub_s(P1[r],dl);} \
      _Pragma("unroll") for(int r=0;r<16;++r)negm[r]=-mhat; asm volatile("":"+v"(negm)); } \
    _Pragma("unroll") for(int r=0;r<16;++r)P0[r]=__builtin_amdgcn_exp2f(P0[r]); }while(0)
  #define RESC() do{ if(resc){ asm volatile("s_waitcnt lgkmcnt(0)":::"memory"); \
      _Pragma("unroll") for(int d_=0;d_<2;++d_) _Pragma("unroll") for(int r=0;r<16;++r)o[d_][r]*=wsf[crow(r,hi)]; } }while(0)
  f32x16 pA0,pA1,pB0,pB1;
  int sl_prev=0,sl_cur=0,sl_next=SLOTB;
  #define ROT() do{sl_prev=sl_cur;sl_cur=sl_next;sl_next=(sl_next==(NSLOT-1)*SLOTB)?0:sl_next+SLOTB;}while(0)
  DMA_K(2,2*SLOTB);
  WAIT_BAR(3);
  qkt(pA0,pA1,Kbase,qr,negm,r32,hi);asm volatile("s_nop 15\n\ts_nop 7":"+v"(pA0),"+v"(pA1));CMASK(pA0,pA1,0);
  START(pA0,pA1);
  _Pragma("unroll") for(int r=0;r<16;++r)pA1[r]=__builtin_amdgcn_exp2f(pA1[r]);
  WAIT_BAR(0);
  DMA_K(3,0);DMA_V(1,SLOTB);
  ROT();
  kload8(kf,kp0+sl_cur);
  WAIT_BAR(2);
  s16x4 vlo[8],vhi[8]; u32x4 pw0,pw1,pw2,pw3;
  #define PKW(P,B) cvtpk_s(P[B],P[B+1])
  #define PAF(k) __builtin_bit_cast(bf16x8,pw##k)
  #define VFR(i) (bf16x8){vlo[i][0],vlo[i][1],vlo[i][2],vlo[i][3],vhi[i][0],vhi[i][1],vhi[i][2],vhi[i][3]}
  #define PIN(x) asm volatile("":"+v"(x))
  #define MX3(a,b,c) __builtin_fmaxf(__builtin_fmaxf((a),(b)),(c))
  #define GAPA(MF,A0,A1,A2,A3,W0,W1,PW) do{ MF; sacc+=A0; sacc+=A1; sacc+=A2; sacc+=A3; PIN(sacc); W0; W1; PIN(PW); SBAR(); }while(0)
  #define EX(v) __builtin_amdgcn_exp2f(v)
  #define GAPB(MF,X,B) do{ MF; X[B]=EX(X[B]); X[B+1]=EX(X[B+1]); X[B+2]=EX(X[B+2]); X[B+3]=EX(X[B+3]); PIN(X); SBAR(); }while(0)
  #define VRD(i) do{ vlo[i]=vtr(vp_+(((i)>>2)*4096+((i)&3)*1024)); vhi[i]=vtr(vp_+(((i)>>2)*4096+((i)&3)*1024+512)); }while(0)
  #define KRD(G,j) do{ if(G){ kload2(kf,kp0+sl_next,j); SBAR(); } }while(0)
  #define STEP(C0,C1,P0,P1,t,GK,GV,GL) do{ SBAR(); \
    const lds_cptr vp_=vp0+sl_prev; \
    VRD(0); SBAR(); float sacc=(P0[0]+P0[1]); \
    GAPA(C0=__builtin_amdgcn_mfma_f32_32x32x16_bf16(kf[0],qr[0],negm,0,0,0), P0[2],P0[3],P0[4],P0[5],     pw0[0]=PKW(P0,0), pw0[1]=PKW(P0,2), pw0); \
    VRD(4); SBAR(); GAPA(C1=__builtin_amdgcn_mfma_f32_32x32x16_bf16(kf[1],qr[0],negm,0,0,0), P0[6],P0[7],P0[8],P0[9],     pw0[2]=PKW(P0,4), pw0[3]=PKW(P0,6), pw0); \
    VRD(1); SBAR(); GAPA(C0=__builtin_amdgcn_mfma_f32_32x32x16_bf16(kf[2],qr[1],C0,0,0,0),   P0[10],P0[11],P0[12],P0[13], pw1[0]=PKW(P0,8), pw1[1]=PKW(P0,10), pw1); \
    VRD(5); SBAR(); GAPA(C1=__builtin_amdgcn_mfma_f32_32x32x16_bf16(kf[3],qr[1],C1,0,0,0),   P0[14],P0[15],P1[0],P1[1],   pw1[2]=PKW(P0,12),pw1[3]=PKW(P0,14), pw1); \
    VRD(2); SBAR(); GAPA(C0=__builtin_amdgcn_mfma_f32_32x32x16_bf16(kf[4],qr[2],C0,0,0,0),   P1[2],P1[3],P1[4],P1[5],     pw2[0]=PKW(P1,0), pw2[1]=PKW(P1,2), pw2); \
    VRD(6); SBAR(); GAPA(C1=__builtin_amdgcn_mfma_f32_32x32x16_bf16(kf[5],qr[2],C1,0,0,0),   P1[6],P1[7],P1[8],P1[9],     pw2[2]=PKW(P1,4), pw2[3]=PKW(P1,6), pw2); \
    VRD(3); SBAR(); GAPA(C0=__builtin_amdgcn_mfma_f32_32x32x16_bf16(kf[6],qr[3],C0,0,0,0),   P1[10],P1[11],P1[12],P1[13], pw3[0]=PKW(P1,8), pw3[1]=PKW(P1,10), pw3); \
    VRD(7); SBAR(); GAPA(C1=__builtin_amdgcn_mfma_f32_32x32x16_bf16(kf[7],qr[3],C1,0,0,0),   P1[14],P1[15],0.f,0.f,       pw3[2]=PKW(P1,12),pw3[3]=PKW(P1,14), pw3); \
    l_reg+=sacc; \
    if(GK){DMA_K((t)+3,sl_cur);} if(GV){DMA_V((t)+1,sl_next);} \
    CMASK(C0,C1,t); \
    { float a=MX3(C0[0],C0[1],C1[0]),b=MX3(C0[2],C0[3],C1[1]); a=MX3(a,C1[2],C1[3]); \
      _Pragma("unroll") for(int r=4;r<16;r+=4){a=MX3(a,C0[r],C0[r+1]);b=MX3(b,C0[r+2],C0[r+3]);a=MX3(a,C1[r],C1[r+1]);b=MX3(b,C1[r+2],C1[r+3]);} \
      float rm=__builtin_fmaxf(a,b); { auto rr=__builtin_amdgcn_permlane32_swap(__float_as_uint(rm),__float_as_uint(rm),false,false); rm=__builtin_fmaxf(__uint_as_float(rr[0]),__uint_as_float(rr[1])); } \
      resc=false; \
      if(__builtin_expect(__any(rm>(float)THRL),0)){ const float dl=__builtin_fmaxf(rm,0.f); mhat+=dl; \
        _Pragma("unroll") for(int r=0;r<16;++r){C0[r]-=dl;C1[r]-=dl;} \
        _Pragma("unroll") for(int r=0;r<16;++r)negm[r]=-mhat; asm volatile("":"+v"(negm)); \
        const float f=__builtin_amdgcn_exp2f(-dl); l_reg*=f; if(hi==0)wsf[r32]=f; resc=true; } } \
    SBAR(); \
    GAPB(o[0]=__builtin_amdgcn_mfma_f32_32x32x16_bf16(PAF(0),VFR(0),o[0],0,0,0), C0,0); \
    GAPB(o[1]=__builtin_amdgcn_mfma_f32_32x32x16_bf16(PAF(0),VFR(4),o[1],0,0,0), C0,4); \
    KRD(GL,0); GAPB(o[0]=__builtin_amdgcn_mfma_f32_32x32x16_bf16(PAF(1),VFR(1),o[0],0,0,0), C0,8); \
    KRD(GL,1); GAPB(o[1]=__builtin_amdgcn_mfma_f32_32x32x16_bf16(PAF(1),VFR(5),o[1],0,0,0), C0,12); \
    KRD(GL,2); GAPB(o[0]=__builtin_amdgcn_mfma_f32_32x32x16_bf16(PAF(2),VFR(2),o[0],0,0,0), C1,0); \
    KRD(GL,3); GAPB(o[1]=__builtin_amdgcn_mfma_f32_32x32x16_bf16(PAF(2),VFR(6),o[1],0,0,0), C1,4); \
    GAPB(o[0]=__builtin_amdgcn_mfma_f32_32x32x16_bf16(PAF(3),VFR(3),o[0],0,0,0), C1,8); \
    GAPB(o[1]=__builtin_amdgcn_mfma_f32_32x32x16_bf16(PAF(3),VFR(7),o[1],0,0,0), C1,12); \
    }while(0)
  int t=1;
  #undef CMASK
  #define CMASK(P0,P1,t) do{}while(0)
#ifdef ATT_LOOP_ALIGN
  asm volatile(ATT_LOOP_ALIGN:::"memory");
#endif
  for(;t+5<NT;t+=2){
    STEP(pB0,pB1,pA0,pA1,t,true,true,true);     WAIT_BAR(2); RESC(); ROT();
    STEP(pA0,pA1,pB0,pB1,t+1,true,true,true);   WAIT_BAR(2); RESC(); ROT();
  }
  #undef CMASK
  #define CMASK(P0,P1,t) do{}while(0)
  #define ENDW(tt) do{ if((tt)+3<NT){WAIT_BAR(2);} else if((tt)+2<NT){WAIT_BAR(1);} else {WAIT_BAR(0);} }while(0)
  for(;t+1<NT;t+=2){
    STEP(pB0,pB1,pA0,pA1,t,(t+3<NT),(t+1<NT),(t+1<NT));       ENDW(t);   RESC(); ROT();
    STEP(pA0,pA1,pB0,pB1,t+1,(t+4<NT),(t+2<NT),(t+2<NT));     ENDW(t+1); RESC(); ROT();
  }
  STEP(pB0,pB1,pA0,pA1,NT-1,false,false,false); RESC();
  { float sacc=pB0[0]+pB0[1]; _Pragma("unroll") for(int r=2;r<16;++r)sacc+=pB0[r]; _Pragma("unroll") for(int r=0;r<16;++r)sacc+=pB1[r]; l_reg+=sacc;
    pw0=(u32x4){PKW(pB0,0),PKW(pB0,2),PKW(pB0,4),PKW(pB0,6)};pw1=(u32x4){PKW(pB0,8),PKW(pB0,10),PKW(pB0,12),PKW(pB0,14)};pw2=(u32x4){PKW(pB1,0),PKW(pB1,2),PKW(pB1,4),PKW(pB1,6)};pw3=(u32x4){PKW(pB1,8),PKW(pB1,10),PKW(pB1,12),PKW(pB1,14)};
    SBAR(); pv(o,vb0+sl_cur,PAF(0),PAF(1),PAF(2),PAF(3)); }
  #undef PKW
  #undef PAF
  #undef VFR
  #undef PIN
  #undef MX3
  #undef GAPA
  #undef GAPB
  #undef EX
  #undef VRD
  #undef KRD
  #undef STEP
  #undef ENDW
  {auto rr=__builtin_amdgcn_permlane32_swap(__float_as_uint(l_reg),__float_as_uint(l_reg),false,false);l_reg=__uint_as_float(rr[0])+__uint_as_float(rr[1]);}
  if(hi==0)wsf[32+r32]=l_reg;asm volatile("s_waitcnt lgkmcnt(0)":::"memory");
  float rli[16];
  #pragma unroll
  for(int r=0;r<16;++r)rli[r]=__builtin_amdgcn_rcpf(wsf[32+crow(r,hi)]);
  bf16*Ow=O+(rowbase+q0+wid*QBLK)*OPITCH+512+h*D;
  { bf16*stg=(bf16*)(shm+LDS_OST)+wid*2048;
    #pragma unroll
    for(int r=0;r<16;++r){const int orow=crow(r,hi);
      #pragma unroll
      for(int d0=0;d0<2;++d0)stg[orow*64+d0*32+r32]=__float2bfloat16(o[d0][r]*rli[r]);}
    asm volatile("s_waitcnt lgkmcnt(0)":::"memory");
    #pragma unroll
    for(int i=0;i<4;++i){const int row=i*8+(lane>>3),ch=lane&7; const u32x4 v=*(const u32x4*)(stg+row*64+ch*8); const u32x4 gt=*(const u32x4*)(shm+LDS_GATE+wid*4096+i*1024+lane*16); u32x4 w;
      _Pragma("unroll") for(int e=0;e<4;++e){ const float a0=__uint_as_float(v[e]<<16)*__uint_as_float(gt[e]<<16), a1=__uint_as_float(v[e]&0xffff0000u)*__uint_as_float(gt[e]&0xffff0000u); w[e]=cvtpk_s(a0,a1); }
      ATTN_STORE16(Ow+(long)row*OPITCH+ch*8,w);} }
  asm volatile("s_waitcnt lgkmcnt(0)\n\ts_barrier":::"memory");
  #undef DMA_K
  #undef DMA_V
  #undef CMASK
  #undef START
  #undef RESC
  #undef ROT
}
constexpr int ATTN_LDS_BYTES=LDS_BYTES;
#undef SBAR
#undef WAIT_BAR
}
namespace ret_body {
using attn_body::bf16x8; using attn_body::s16x4; using attn_body::f32x16; using attn_body::u32x4; using attn_body::glds16; using attn_body::vtr; using attn_body::cvtpk_s; using attn_body::crow; using attn_body::lds_cptr;
typedef unsigned u32x2 __attribute__((ext_vector_type(2)));
typedef float f32x4 __attribute__((ext_vector_type(4)));
constexpr int PP = 128; constexpr long HSZ = (long)81920 * 128; constexpr int QOFF = 0, KOFF = 4, VOFF = 8, GOFF = 12;
constexpr float LOG2E = 1.4426950408889634f;
#define RB_WAITV0_BAR() asm volatile("s_waitcnt vmcnt(0) lgkmcnt(0)\n\ts_barrier" ::: "memory")
#define RB_BAR() asm volatile("s_waitcnt lgkmcnt(0)\n\ts_barrier" ::: "memory")
__device__ __forceinline__ size_t rt_off(int dir, int cgl, int h) { return ((size_t)(dir * 640 + cgl) * 4 + h) * 32768; }
__device__ __forceinline__ s16x4 scale4(s16x4 v, float w0, float w1, float w2, float w3) {
    const u32x2 u = __builtin_bit_cast(u32x2, v); u32x2 o;
    o[0] = cvtpk_s(__uint_as_float(u[0] << 16) * w0, __uint_as_float(u[0] & 0xffff0000u) * w1);
    o[1] = cvtpk_s(__uint_as_float(u[1] << 16) * w2, __uint_as_float(u[1] & 0xffff0000u) * w3);
    return __builtin_bit_cast(s16x4, o);
}
__device__ __forceinline__ bf16x8 scale8(bf16x8 v, float w) {
    const u32x4 u = __builtin_bit_cast(u32x4, v); u32x4 o;
#pragma unroll
    for (int e = 0; e < 4; ++e) o[e] = cvtpk_s(__uint_as_float(u[e] << 16) * w, __uint_as_float(u[e] & 0xffff0000u) * w);
    return __builtin_bit_cast(bf16x8, o);
}
__device__ __forceinline__ void dma_timg(const bf16* P, long row0, int slot, unsigned dst, int wid, int lane) { P += slot * HSZ;
#pragma unroll
    for (int i = 0; i < 4; ++i) { const int p = wid * 4 + i, db = p >> 3, kg = p & 7;
        glds16(P + (row0 + 16 * kg + (lane >> 2)) * PP + db * 32 + (lane & 3) * 8, (unsigned)__builtin_amdgcn_readfirstlane(dst + p * 1024)); }
}
__device__ __forceinline__ void dma_kimg(const bf16* P, long row0, int slot, unsigned dst, int wid, int lane) { P += slot * HSZ;
#pragma unroll
    for (int i = 0; i < 4; ++i) { const int p = wid * 4 + i, c16 = p >> 1, th = p & 1;
        glds16(P + (row0 + 64 * th + lane) * PP + c16 * 8, (unsigned)__builtin_amdgcn_readfirstlane(dst + p * 1024)); }
}
__device__ __forceinline__ void dma_lin(const unsigned char* src, unsigned dst, int wid, int lane) {
#pragma unroll
    for (int i = 0; i < 4; ++i) { const int p = wid * 4 + i; glds16(src + p * 1024 + lane * 16, (unsigned)__builtin_amdgcn_readfirstlane(dst + p * 1024)); }
}


#define RB_WAITV(n) asm volatile("s_waitcnt vmcnt(" #n ") lgkmcnt(0)\n\ts_barrier" ::: "memory")
#define RB_TOPX(rem) do { RB_TOP(rem); if (EXP == 4) { __builtin_amdgcn_s_sleep(32); } } while (0)
#define RB_TOP(rem) do { if ((rem) >= 2) RB_WAITV(8); else if ((rem) == 1) RB_WAITV(4); else RB_WAITV(0); } while (0)

__device__ __forceinline__ void dma_timg8(const bf16* P, long row0, int slot, unsigned dst, int lw, int lane) { P += slot * HSZ;
#pragma unroll
    for (int i = 0; i < 8; ++i) { const int p = lw * 8 + i, db = p >> 3, kg = p & 7;
        glds16(P + (row0 + 16 * kg + (lane >> 2)) * PP + db * 32 + (lane & 3) * 8, (unsigned)__builtin_amdgcn_readfirstlane(dst + p * 1024)); }
}
__device__ __forceinline__ void dma_kimg8(const bf16* P, long row0, int slot, unsigned dst, int lw, int lane) { P += slot * HSZ;
#pragma unroll
    for (int i = 0; i < 8; ++i) { const int p = lw * 8 + i, c16 = p >> 1, th = p & 1;
        glds16(P + (row0 + 64 * th + lane) * PP + c16 * 8, (unsigned)__builtin_amdgcn_readfirstlane(dst + p * 1024)); }
}
__device__ __forceinline__ void dma_lin8(const unsigned char* src, unsigned dst, int lw, int lane) {
#pragma unroll
    for (int i = 0; i < 8; ++i) { const int p = lw * 8 + i; glds16(src + p * 1024 + lane * 16, (unsigned)__builtin_amdgcn_readfirstlane(dst + p * 1024)); }
}
#define RB_WAITL(n) asm volatile("s_waitcnt vmcnt(" #n ") lgkmcnt(0)\n\ts_barrier" ::: "memory")
#define RB_TOPL(rem) do { if ((rem) >= 2) RB_WAITL(16); else if ((rem) == 1) RB_WAITL(8); else RB_WAITL(0); } while (0)
#define RB_TOPC() asm volatile("s_waitcnt lgkmcnt(0)\n\ts_barrier" ::: "memory")

__device__ __forceinline__ void scan_dma(const bf16* P, int cgl, int half, int h, unsigned slot, int lw, int lane) {
#pragma unroll
    for (int i = 0; i < 8; ++i) { const int p = lw * 8 + i, mat = p >> 4, q = p & 15;
        const unsigned char* src = (const unsigned char*)(P + ((mat ? VOFF : KOFF) + h) * HSZ + (long)cgl * 16384) + (mat ? (q >> 2) * 8192 + (4 * half + (q & 3)) * 1024 : q * 2048 + half * 1024) + lane * 16;
        glds16(src, (unsigned)__builtin_amdgcn_readfirstlane(slot + mat * 16384 + q * 1024)); }
}
__device__ __forceinline__ void scan_item(int b, int h, int dir, const bf16* P, unsigned char* RT, const float* lrf, const float* lrb, char* shm) {
    int tid = threadIdx.x; asm volatile("" : "+v"(tid));
    const int lane = tid & 63, r32 = lane & 31, hi = lane >> 5; const int wid = __builtin_amdgcn_readfirstlane(tid >> 6);
    const long rowbase = b < 4 ? (long)b * 4096 : (long)NTOK_P + (long)(b - 4) * 2048; const int N = b < 4 ? 32 : 16, J = 2 * N;
    const unsigned lds0 = (unsigned)(uintptr_t)shm; const lds_cptr shm3 = (lds_cptr)shm;
    const int n0 = dir ? N - 1 : 0, dn = dir ? -1 : 1;
#define SC_CG(j) ((int)(rowbase >> 7) + n0 + ((j) >> 1) * dn)
    if (wid >= 4) {
        const int lw = wid - 4;
        scan_dma(P, SC_CG(0), 0, h, lds0, lw, lane); scan_dma(P, SC_CG(1), 1, h, lds0 + 32768, lw, lane); scan_dma(P, SC_CG(2), 0, h, lds0 + 65536, lw, lane);
        for (int j = 0; j < J; ++j) {
            RB_TOPL(J - 1 - j);
            if (j + 3 < J) scan_dma(P, SC_CG(j + 3), (j + 3) & 1, h, lds0 + ((j + 3) & 3) * 32768, lw, lane);
        }
        RB_TOPC();
    } else {
        const float lg = -__expf(dir ? lrb[h] : lrf[h]) * LOG2E;
        const float gC = __builtin_amdgcn_exp2f(lg * 128.f);
        const int db = wid;
        const int troff = ((lane >> 4) & 1) * 32 + (lane & 3) * 8 + (4 * hi + ((lane & 15) >> 2)) * 64;
        f32x16 st[4]; st[0] = f32x16{}; st[1] = f32x16{}; st[2] = f32x16{}; st[3] = f32x16{};
        float wj[8];
#pragma unroll
        for (int j = 0; j < 8; ++j) { const int oj = 8 * (j >> 2) + 4 * hi + (j & 3); wj[j] = __builtin_amdgcn_exp2f(lg * (float)(dir ? oj : 15 - oj)); }
        for (int j = 0; j < J; ++j) {
            const int half = j & 1, slot = (j & 3) * 32768;
            RB_TOPC();
            if (half == 0) {
                unsigned char* img = RT + rt_off(dir, (int)((rowbase >> 7) + n0 + (j >> 1) * dn), h);
#pragma unroll
                for (int et = 0; et < 4; ++et) { const int e = 32 * et + r32;
#pragma unroll
                    for (int rp = 0; rp < 2; ++rp) {
                        u32x2 w[2];
#pragma unroll
                        for (int k = 0; k < 2; ++k) { const int r4 = 2 * rp + k; w[k][0] = cvtpk_s(st[et][4 * r4], st[et][4 * r4 + 1]); w[k][1] = cvtpk_s(st[et][4 * r4 + 2], st[et][4 * r4 + 3]); }
                        const auto s0 = __builtin_amdgcn_permlane32_swap(w[0][0], w[1][0], false, false), s1 = __builtin_amdgcn_permlane32_swap(w[0][1], w[1][1], false, false);
                        *(u32x4*)(img + (4 * db + 2 * rp + hi) * 2048 + e * 16) = (u32x4){s0[0], s1[0], s0[1], s1[1]}; }
#pragma unroll
                    for (int r = 0; r < 16; ++r) st[et][r] *= gC; } }
            const lds_cptr kb = shm3 + slot + (4 * db + 2 * ((lane >> 4) & 1) + ((lane & 3) >> 1)) * 1024 + (4 * hi + ((lane & 15) >> 2)) * 16 + (lane & 1) * 8, vb = shm3 + slot + 16384 + troff;
#pragma unroll
            for (int ks = 0; ks < 4; ++ks) {
                s16x4 klo = vtr(kb + ks * 256), khi = vtr(kb + ks * 256 + 128);
                const float bk = __builtin_amdgcn_exp2f(lg * (float)(dir ? 64 * half + 16 * ks : 112 - 64 * half - 16 * ks));
                float w[8];
#pragma unroll
                for (int jj = 0; jj < 8; ++jj) w[jj] = wj[jj] * bk;
                klo = scale4(klo, w[0], w[1], w[2], w[3]); khi = scale4(khi, w[4], w[5], w[6], w[7]);
                const bf16x8 af = (bf16x8){klo[0], klo[1], klo[2], klo[3], khi[0], khi[1], khi[2], khi[3]};
#pragma unroll
                for (int et = 0; et < 4; ++et) { const s16x4 vlo = vtr(vb + et * 4096 + ks * 1024), vhi = vtr(vb + et * 4096 + ks * 1024 + 512);
                    const bf16x8 bfr = (bf16x8){vlo[0], vlo[1], vlo[2], vlo[3], vhi[0], vhi[1], vhi[2], vhi[3]};
                    st[et] = __builtin_amdgcn_mfma_f32_32x32x16_bf16(af, bfr, st[et], 0, 0, 0); }
            }
        }
        RB_TOPC();
    }
#undef SC_CG
}

template <class Sched, int EXP = 0> __device__ __forceinline__ void retout_phase(const Sched& S, int nit, const bf16* P, const unsigned char* RT, bf16* O, const float* lrf, const float* lrb, const float* gng, char* shm) {
    int tid = threadIdx.x; asm volatile("" : "+v"(tid));
    const int lane = tid & 63, r32 = lane & 31, hi = lane >> 5; const int wid = __builtin_amdgcn_readfirstlane(tid >> 6);
    const unsigned lds0 = (unsigned)(uintptr_t)shm; const lds_cptr shm3 = (lds_cptr)shm;
    const int G = 6 * nit;
    float* gn_l = (float*)(shm + 131072); float* lg_l = gn_l + 512;
    gn_l[tid] = gng[tid]; if (tid < 8) lg_l[tid] = -__expf(tid < 4 ? lrf[tid] : lrb[tid - 4]) * LOG2E;
    asm volatile("s_waitcnt vmcnt(0) lgkmcnt(0)" ::: "memory");
    if (nit <= 0) return;
    if (wid >= 4) {
        const int lw = wid - 4;
#define RO_ISSUE(g_) do { const int gq_ = (g_); if (EXP != 3 && gq_ < G) { const int it_ = gq_ / 6, st_ = gq_ - 6 * it_; int cg_, h_; S.item(it_, cg_, h_); const long r0_ = (long)cg_ * 128; const unsigned dst_ = lds0 + ((gq_ & 3) << 15); \
        if (st_ == 0) dma_lin8((const unsigned char*)(P + (QOFF + h_) * HSZ + (long)cg_ * 16384), dst_, lw, lane); else if (st_ == 1) dma_lin8((const unsigned char*)(P + (KOFF + h_) * HSZ + (long)cg_ * 16384), dst_, lw, lane); \
        else if (st_ == 2) dma_lin8((const unsigned char*)(P + (VOFF + h_) * HSZ + (long)cg_ * 16384), dst_, lw, lane); else if (st_ == 3) dma_lin8(RT + rt_off(0, cg_, h_), dst_, lw, lane); \
        else if (st_ == 4) dma_lin8(RT + rt_off(1, cg_, h_), dst_, lw, lane); else dma_lin8((const unsigned char*)(P + (GOFF + h_) * HSZ + (long)cg_ * 16384), dst_, lw, lane); } } while (0)
        RO_ISSUE(0); RO_ISSUE(1); RO_ISSUE(2);
        for (int g = 0; g < G; ++g) { RB_TOPL(G - 1 - g); RO_ISSUE(g + 3); }
        RB_TOPC();
#undef RO_ISSUE
        return;
    }
    const int cw = wid, c = 32 * cw + r32;
    const int troff = ((lane >> 4) & 1) * 32 + (lane & 3) * 8 + (4 * hi + ((lane & 15) >> 2)) * 64;
    for (int i = 0; i < nit; ++i) {
        int cgl, h; S.item(i, cgl, h);
        const long row0 = (long)cgl * 128; const int g0 = 6 * i;
        bf16x8 qr[8]; u32x4 pw[8]; f32x16 o[4]; o[0] = f32x16{}; o[1] = f32x16{}; o[2] = f32x16{}; o[3] = f32x16{};
        RB_TOPC();
        { const lds_cptr qp = shm3 + ((g0 & 3) << 15) + hi * 2048 + c * 16;
#pragma unroll
          for (int s = 0; s < 8; ++s) qr[s] = *(const __attribute__((address_space(3))) bf16x8*)(qp + s * 4096); }
        const float lgf = lg_l[h], lgb = lg_l[4 + h], nlgb = -lgb; float cfb = (float)(c - 4 * hi); asm volatile("" : "+v"(cfb));
        RB_TOPC();
        { const lds_cptr kp = shm3 + (((g0 + 1) & 3) << 15) + hi * 2048 + r32 * 16;
#pragma unroll
          for (int kb = 0; kb < 4; ++kb) {
              f32x16 p = f32x16{};
#pragma unroll
              for (int s = 0; s < 8; ++s) { const bf16x8 kf = *(const __attribute__((address_space(3))) bf16x8*)(kp + s * 4096 + kb * 512); p = __builtin_amdgcn_mfma_f32_32x32x16_bf16(kf, qr[s], p, 0, 0, 0); }
#pragma unroll
              for (int r = 0; r < 16; ++r) { const float x = cfb - (float)(32 * kb + (r & 3) + 8 * (r >> 2)); p[r] *= __builtin_amdgcn_exp2f((x >= 0.f ? lgf : nlgb) * x); }
#pragma unroll
              for (int e = 0; e < 4; ++e) { pw[2 * kb][e] = cvtpk_s(p[2 * e], p[2 * e + 1]); pw[2 * kb + 1][e] = cvtpk_s(p[8 + 2 * e], p[8 + 2 * e + 1]); }
              __builtin_amdgcn_sched_barrier(0);
          } }
        RB_TOPC();
        { const lds_cptr vb = shm3 + (((g0 + 2) & 3) << 15) + troff;
#pragma unroll
          for (int ks = 0; ks < 8; ++ks)
#pragma unroll
              for (int d0 = 0; d0 < 4; ++d0) { const s16x4 vlo = vtr(vb + d0 * 8192 + ks * 1024), vhi = vtr(vb + d0 * 8192 + ks * 1024 + 512);
                  o[d0] = __builtin_amdgcn_mfma_f32_32x32x16_bf16((bf16x8){vlo[0], vlo[1], vlo[2], vlo[3], vhi[0], vhi[1], vhi[2], vhi[3]}, __builtin_bit_cast(bf16x8, pw[ks]), o[d0], 0, 0, 0); if (d0 == 3 && (ks & 1)) __builtin_amdgcn_sched_barrier(0); } }
#pragma unroll
        for (int dir = 0; dir < 2; ++dir) {
            RB_TOPC();
            const float dec = __builtin_amdgcn_exp2f(dir ? lgb * (float)(128 - c) : lgf * (float)(c + 1));
            const lds_cptr rp = shm3 + (((g0 + 3 + dir) & 3) << 15) + hi * 2048 + r32 * 16;
#pragma unroll
            for (int s = 0; s < 8; ++s) { const bf16x8 qs = scale8(qr[s], dec);
#pragma unroll
                for (int d0 = 0; d0 < 4; ++d0) { const bf16x8 rf = *(const __attribute__((address_space(3))) bf16x8*)(rp + s * 4096 + d0 * 512); o[d0] = __builtin_amdgcn_mfma_f32_32x32x16_bf16(rf, qs, o[d0], 0, 0, 0); }
                if (s & 1) __builtin_amdgcn_sched_barrier(0); }
        }
        float rs;
        { float ss = 0.f;
#pragma unroll
          for (int d0 = 0; d0 < 4; ++d0)
#pragma unroll
              for (int r = 0; r < 16; ++r) ss += o[d0][r] * o[d0][r];
          const auto rr = __builtin_amdgcn_permlane32_swap(__float_as_uint(ss), __float_as_uint(ss), false, false); ss = __uint_as_float(rr[0]) + __uint_as_float(rr[1]);
          rs = rsqrtf(ss * (1.f / 128.f) + EPS); }
        RB_TOPC();
        { const lds_cptr gp = shm3 + (((g0 + 5) & 3) << 15) + c * 16 + 8 * hi;
          bf16* Ow = O + (row0 + c) * 1024 + h * 128;
#pragma unroll
          for (int d0 = 0; d0 < 4; ++d0)
#pragma unroll
              for (int rp = 0; rp < 2; ++rp) {
                  u32x2 w[2];
#pragma unroll
                  for (int k = 0; k < 2; ++k) { const int r4 = 2 * rp + k, e0 = 32 * d0 + 8 * r4 + 4 * hi;
                      const u32x2 gt = *(const __attribute__((address_space(3))) u32x2*)(gp + (4 * d0 + r4) * 2048); const f32x4 gn = *(const f32x4*)(gn_l + h * 128 + e0);
                      w[k][0] = cvtpk_s(o[d0][4 * r4] * rs * gn[0] * __uint_as_float(gt[0] << 16), o[d0][4 * r4 + 1] * rs * gn[1] * __uint_as_float(gt[0] & 0xffff0000u));
                      w[k][1] = cvtpk_s(o[d0][4 * r4 + 2] * rs * gn[2] * __uint_as_float(gt[1] << 16), o[d0][4 * r4 + 3] * rs * gn[3] * __uint_as_float(gt[1] & 0xffff0000u)); }
                  const auto s0 = __builtin_amdgcn_permlane32_swap(w[0][0], w[1][0], false, false), s1 = __builtin_amdgcn_permlane32_swap(w[0][1], w[1][1], false, false);
                  const u32x4 ww = {s0[0], s1[0], s0[1], s1[1]};
                  bf16* dst = Ow + 32 * d0 + 8 * (2 * rp + hi);
#if WT_STORES
                  attn_body::store16_sc1(dst, ww);
#else
                  *(u32x4*)dst = ww;
#endif
              } }
    }
    RB_TOPC();
}
}
#define RLX_AGENT __ATOMIC_RELAXED, __HIP_MEMORY_SCOPE_AGENT
#define XB_TMO      128
#define XB_XCNT(j)  (256  + 64 * (j))
#define XB_XSUB(j)  (1280 + 64 * (j))
#define XB_XGEN(j)  (2304 + 64 * (j))
#define XB_TOP      3328
#define XB_TOPGEN   3392
#define XCD_BAR_WORDS 3456
#define XB_SPIN_CAP (1u << 18)

__device__ __forceinline__ unsigned xb_ld(unsigned* p)              { return __hip_atomic_load(p, __ATOMIC_RELAXED, __HIP_MEMORY_SCOPE_AGENT); }
__device__ __forceinline__ unsigned xb_add(unsigned* p, unsigned v) { return __hip_atomic_fetch_add(p, v, __ATOMIC_RELAXED, __HIP_MEMORY_SCOPE_AGENT); }
__device__ __forceinline__ unsigned xb_xcc_id() { return (unsigned)__builtin_amdgcn_s_getreg((3 << 11) | 20) & 0xFu; }
#define XB_SPIN(cond, bar) do { unsigned _sp = 0; while (cond) { __builtin_amdgcn_s_sleep(1); \
    if ((++_sp & 255u) == 0u) { if (xb_ld(&(bar)[XB_TMO])) break; if (_sp > XB_SPIN_CAP) { atomicAdd(&(bar)[XB_TMO], 1u); break; } } } } while (0)

struct XcdBarrier {
    unsigned* bar; unsigned x;
    volatile LAS unsigned* st;
};

__device__ __forceinline__ XcdBarrier xcd_barrier_post(unsigned* bar, volatile LAS unsigned* st) {
    XcdBarrier b; b.bar = bar; b.x = xb_xcc_id(); b.st = st;
    if (threadIdx.x == 0) (void)xb_add(&bar[XB_XCNT(b.x)], 1u);
    return b;
}
__device__ __forceinline__ void xcd_barrier_complete(unsigned* bar, unsigned x, unsigned& nloc, unsigned& nx) {
    const unsigned G = gridDim.x * gridDim.y * gridDim.z;
    unsigned sum, cnt, mine, sp = 0u;
    for (;;) {
        sum = 0u; cnt = 0u; mine = 0u;
#pragma unroll
        for (unsigned j = 0; j < 16; ++j) { const unsigned c = xb_ld(&bar[XB_XCNT(j)]); sum += c; cnt += (c > 0u) ? 1u : 0u; mine = (j == x) ? c : mine; }
        if (sum == G) break;
        __builtin_amdgcn_s_sleep(1);
        if ((++sp & 255u) == 0u) { if (xb_ld(&bar[XB_TMO])) break; if (sp > XB_SPIN_CAP) { atomicAdd(&bar[XB_TMO], 1u); break; } }
    }
    nloc = mine > 0u ? mine : 1u; nx = cnt > 0u ? cnt : 1u;
}

__device__ __forceinline__ void xcd_barrier(const XcdBarrier& b) {
    asm volatile("s_waitcnt vmcnt(0)" ::: "memory");
    __syncthreads();
    if (threadIdx.x == 0) {
        unsigned* bar = b.bar;
        __builtin_amdgcn_s_waitcnt(0);
        unsigned nloc = b.st[0], nx = b.st[1];
        if (nloc == 0u) { xcd_barrier_complete(bar, b.x, nloc, nx); b.st[0] = nloc; b.st[1] = nx; }
        const unsigned old = xb_add(&bar[XB_XSUB(b.x)], 1u);
        const unsigned gen = old / nloc;
        if (old + 1u == (gen + 1u) * nloc) {
            __builtin_amdgcn_fence(__ATOMIC_RELEASE, "agent");
            asm volatile("s_waitcnt vmcnt(0)" ::: "memory");
            const unsigned og = xb_add(&bar[XB_TOP], 1u);
            const unsigned tg = og / nx;
            if (og + 1u == (tg + 1u) * nx) xb_add(&bar[XB_TOPGEN], 1u);
            else XB_SPIN(xb_ld(&bar[XB_TOPGEN]) == tg, bar);
            __builtin_amdgcn_fence(__ATOMIC_ACQUIRE, "agent");
            xb_add(&bar[XB_XGEN(b.x)], 1u);
            asm volatile("s_waitcnt vmcnt(0)" ::: "memory");
        } else {
            XB_SPIN(xb_ld(&bar[XB_XGEN(b.x)]) == gen, bar);
            __builtin_amdgcn_fence(__ATOMIC_ACQUIRE, "agent");
            asm volatile("s_waitcnt vmcnt(0)" ::: "memory");
        }
    }
    __syncthreads();
}
constexpr int NWAVES = 8, NTHREADS = 512;
constexpr int RING_BYTES = 131072, LDS_PERSIST = 147456, LDS_TABA = 147456 + 256, LDS_BYTES = 147456 + 256 + 8192;
#define LDS_WAIT() asm volatile("s_waitcnt lgkmcnt(0)" ::: "memory")

struct Args { const float* in[14]; float* out; unsigned char* ws; int ph_lo, ph_hi; };

__device__ __forceinline__ void p0_mod_item(const Args& a, LAS unsigned char* lds, int item) {
    typedef float f4 __attribute__((ext_vector_type(4)));
    const int tid = threadIdx.x, lane = tid & 63, wave = tid >> 6, col = tid & 15, kl = tid >> 4, n0 = item * 16;
    const float* cp = a.in[2]; const float* cs = a.in[3]; const float* W = a.in[5]; const float* bias = a.in[6]; float* mod = (float*)(a.ws + WS_MOD);
    LAS float* sl = (LAS float*)lds;
    LAS float* red = (LAS float*)(lds + 40960);
    float acc[NB];
#pragma unroll
    for (int b = 0; b < NB; ++b) acc[b] = 0.f;
    float wv[4][8];
#pragma unroll
    for (int kc = 0; kc < 4; ++kc)
#pragma unroll
        for (int i = 0; i < 8; ++i) wv[kc][i] = W[(size_t)(kc * 256 + kl + 32 * i) * 3072 + n0 + col];
#pragma unroll
    for (int kc = 0; kc < 4; ++kc) {
        float wc[8];
#pragma unroll
        for (int i = 0; i < 8; ++i) wc[i] = wv[kc][i];
        __syncthreads();
        { float cv[18];
#pragma unroll
          for (int q = 0; q < 18; ++q) { const int e = tid + q * NTHREADS, b = e >> 8, k = e & 255; const float* c = b < 4 ? cp + b * DM : cs + (b - 4) * DM; cv[q] = c[kc * 256 + k]; }
#pragma unroll
          for (int q = 0; q < 18; ++q) { const int e = tid + q * NTHREADS, b = e >> 8, k = e & 255; sl[(k & 31) * 292 + b * 8 + (k >> 5)] = silu(cv[q]); } }
        __syncthreads();
#pragma unroll
        for (int b = 0; b < NB; ++b) { const f4 s0 = *(const LAS f4*)(sl + kl * 292 + b * 8), s1 = *(const LAS f4*)(sl + kl * 292 + b * 8 + 4);
            acc[b] += (s0[0] * wc[0] + s0[1] * wc[1]) + (s0[2] * wc[2] + s0[3] * wc[3]) + (s1[0] * wc[4] + s1[1] * wc[5]) + (s1[2] * wc[6] + s1[3] * wc[7]); }
    }
#pragma unroll
    for (int b = 0; b < NB; ++b) { acc[b] += __shfl_xor(acc[b], 16); acc[b] += __shfl_xor(acc[b], 32); }
    __syncthreads();
    if (lane < 16) {
#pragma unroll
        for (int b = 0; b < NB; ++b) red[(wave * NB + b) * 16 + col] = acc[b]; }
    __syncthreads();
    for (int e = tid; e < NB * 16; e += NTHREADS) { const int b = e >> 4, c = e & 15; float s = 0.f;
        for (int w = 0; w < 8; ++w) s += red[(w * NB + b) * 16 + c];
        mod[b * 3072 + n0 + c] = s + bias[n0 + c]; }
    __syncthreads();
}
__device__ __forceinline__ void p0_transpose_item(const float* W, int K, int N, bf16* WT, bool perm, LAS float* scr, int item, int lane) {
    const int nblk = N / 32, kb = item / nblk, nb = item % nblk, k0 = 64 * kb, n0 = 32 * nb;
    float t_[32];
#pragma unroll
    for (int i = 0; i < 32; ++i) t_[i] = W[(size_t)(k0 + 2 * i + (lane >> 5)) * N + n0 + (lane & 31)];
#pragma unroll
    for (int i = 0; i < 32; ++i) scr[(2 * i + (lane >> 5)) * 33 + (lane & 31)] = t_[i];
    LDS_WAIT(); asm volatile("" ::: "memory");
    const int c = lane & 7;
#pragma unroll
    for (int j = 0; j < 4; ++j) { const int n = (lane >> 3) + 8 * j; const LAS float* s = scr + (8 * c) * 33 + n;
        uint4 o; o.x = pk2(s[0 * 33], s[1 * 33]); o.y = pk2(s[2 * 33], s[3 * 33]); o.z = pk2(s[4 * 33], s[5 * 33]); o.w = pk2(s[6 * 33], s[7 * 33]);
        *(uint4*)(WT + (size_t)(perm ? pg8::in_physrow(n0 + n) : n0 + n) * K + k0 + 8 * c) = o; }
    LDS_WAIT(); asm volatile("" ::: "memory");
}
__device__ __forceinline__ void p0_prologue(const Args& a, LAS unsigned char* lds) {
    const int tid = threadIdx.x, lane = tid & 63, wave = __builtin_amdgcn_readfirstlane(tid >> 6), G = gridDim.x;
    for (int it = blockIdx.x; it < 192; it += G) p0_mod_item(a, lds, it);
#ifdef DBL_MOD
    for (int it = blockIdx.x; it < 192; it += G) p0_mod_item(a, lds, it);
#endif
    __syncthreads();
    if ((int)blockIdx.x == G - 1) {
        float* tabR = (float*)(a.ws + WS_TAB); float* tabA = tabR + 4096;
        for (int e = tid; e < 2048; e += NTHREADS) { const int pos = e >> 5, i = e & 31; float sn, cs; sincosf((float)pos * powf(10000.f, -(float)i / 32.f), &sn, &cs); tabR[e] = cs; tabR[2048 + e] = sn; }
        for (int e = tid; e < 1024; e += NTHREADS) { const int pos = e >> 4, i = e & 15; float sn, cs; sincosf((float)pos * powf(10000.f, -(float)i / 16.f), &sn, &cs); tabA[e] = cs; tabA[1024 + e] = sn; }
    }
    LAS float* scr = (LAS float*)(lds + wave * 16384);
    const int gw = (G - 1 - (int)blockIdx.x) * NWAVES + wave, NGW = G * NWAVES;
    constexpr int I_IN = (DM / 64) * (INC / 32), I_OUT = (DM / 64) * (DM / 32);
    for (int it = gw; it < I_IN + I_OUT; it += NGW) {
        if (it < I_IN) p0_transpose_item(a.in[7], DM, INC, (bf16*)(a.ws + WS_WIN), true, scr, it, lane);
        else p0_transpose_item(a.in[13], DM, DM, (bf16*)(a.ws + WS_WOUT), false, scr, it - I_IN, lane);
    }
}
__device__ __forceinline__ void p1_norm(const Args& a) {
    typedef float f4 __attribute__((ext_vector_type(4)));
    const int tid = threadIdx.x, lane = tid & 63, wave = tid >> 6; const int gw = blockIdx.x * NWAVES + wave, NGW = gridDim.x * NWAVES;
    const float* mod = (const float*)(a.ws + WS_MOD); bf16* H = (bf16*)(a.ws + WS_H);
    const int per = (M + NGW - 1) / NGW; int curb = -1; f4 gs[4], sh[4];
    for (int m = gw * per; m < M && m < (gw + 1) * per; ++m) {
        const int b = batch_of(m);
        if (b != curb) { curb = b;
#pragma unroll
            for (int j = 0; j < 4; ++j) { const f4 g = ((const f4*)a.in[4])[lane + 64 * j], sc = ((const f4*)(mod + b * 3072 + 1024))[lane + 64 * j]; gs[j] = g * (1.f + sc); sh[j] = ((const f4*)(mod + b * 3072))[lane + 64 * j]; } }
        const float* x = m < NTOK_P ? a.in[0] + (size_t)m * DM : a.in[1] + (size_t)(m - NTOK_P) * DM;
        f4 v[4]; float s = 0.f;
#pragma unroll
        for (int j = 0; j < 4; ++j) { v[j] = ((const f4*)x)[lane + 64 * j]; s += (v[j][0] * v[j][0] + v[j][1] * v[j][1]) + (v[j][2] * v[j][2] + v[j][3] * v[j][3]); }
#pragma unroll
        for (int o = 1; o < 64; o <<= 1) s += __shfl_xor(s, o);
        const float r = rsqrtf(s * (1.f / DM) + EPS);
        unsigned long long* o8 = (unsigned long long*)(H + (size_t)m * DM) + lane;
#pragma unroll
        for (int j = 0; j < 4; ++j) { const f4 y = v[j] * r * gs[j] + sh[j]; o8[64 * j] = (unsigned long long)pk2(y[0], y[1]) | ((unsigned long long)pk2(y[2], y[3]) << 32); }
    }
}
#ifndef MERGED_MIX
#define MERGED_MIX 1
#endif
#ifndef MX_ORDER
#define MX_ORDER 0
#endif
#ifndef FUSED_NORM
#define FUSED_NORM 1
#endif
#ifndef NOFENCE
#define NOFENCE 0
#endif

__device__ __forceinline__ void p3_scan(const Args& a, char* shm) {
    for (int it = blockIdx.x; it < 288; it += gridDim.x) {
        int b, h, dir;
        if (it < 32) { b = it >> 3; h = (it >> 1) & 3; dir = it & 1; } else { const int j = it - 32; b = 4 + (j >> 3); h = (j >> 1) & 3; dir = j & 1; }
        ret_body::scan_item(b, h, dir, (const bf16*)(a.ws + WS_PROJ), a.ws + WS_RT, a.in[8], a.in[9], shm);
    }
}
struct RetStatic { int base, G; __device__ __forceinline__ void item(int i, int& cgl, int& h) const { const int it = base + i * G; cgl = it >> 2; h = it & 3; } };
template <int EXP = 0> __device__ __forceinline__ void p4_retout(const Args& a, char* shm) {
    const RetStatic S{(int)blockIdx.x, (int)gridDim.x}; const int nit = (2560 - (int)blockIdx.x + (int)gridDim.x - 1) / (int)gridDim.x;
    ret_body::retout_phase<RetStatic, EXP>(S, nit, (const bf16*)(a.ws + WS_PROJ), a.ws + WS_RT, (bf16*)(a.ws + WS_MIX), a.in[8], a.in[9], a.in[10], shm);
}
template <int MAP = 0, int ROT = 0> __device__ __forceinline__ void p5_attn(const Args& a, char* shm) {
    const int G = gridDim.x; const attn_body::bf16* P = (const attn_body::bf16*)(a.ws + WS_PROJ); attn_body::bf16* O = (attn_body::bf16*)(a.ws + WS_MIX);
    if (G == 256) {
        const int x = MAP == 0 ? (blockIdx.x & 7) : (blockIdx.x >> 5), j = MAP == 0 ? (blockIdx.x >> 3) : (blockIdx.x & 31);
        for (int i = 0; i < 10; ++i) {
            if (i < 2) { const int u = i * 32 + j, b = x >> 1, kvh = x & 1; attn_body::attn_unit<8>((long)b * 4096, 4096, kvh * 4 + (u & 3), u >> 2, ROT ? (u * ROT) & 63 : 0, P, O, shm); }
            else { const int gi = x * 8 + (i - 2), b = gi >> 1, kvh = gi & 1; attn_body::attn_unit<8>((long)NTOK_P + (long)b * 2048, 2048, kvh * 4 + (j & 3), j >> 2, ROT ? (j * ROT) & 31 : 0, P, O, shm); }
        }
    } else {
        for (int it = blockIdx.x; it < 2560; it += G) {
            if (it < 512) { const int b = it >> 7, h = (it >> 4) & 7, qb = it & 15; attn_body::attn_unit<8>((long)b * 4096, 4096, h, qb, 0, P, O, shm); }
            else { const int j = it - 512, b = j >> 6, h = (j >> 3) & 7, qb = j & 7; attn_body::attn_unit<8>((long)NTOK_P + (long)b * 2048, 2048, h, qb, 0, P, O, shm); }
        }
    }
}

constexpr int MX_LIST = 36 + 64 + 40 + 256;
__device__ __forceinline__ unsigned* ctl_q(const Args& a, int x) { return (unsigned*)(a.ws + WS_CTL) + 64 * x; }
__device__ __forceinline__ unsigned* ctl_sd(const Args& a, int b, int h) { return (unsigned*)(a.ws + WS_CTL) + 1024 + 64 * (4 * b + h); }
__device__ __forceinline__ unsigned* ctl_pc(const Args& a, int pm) { return (unsigned*)(a.ws + WS_CTL) + 16384 + 64 * pm; }
__device__ __forceinline__ unsigned* ctl_q6(const Args& a, int x) { return (unsigned*)(a.ws + WS_CTL) + 12288 + 64 * x; }
constexpr int CTL_ZERO_WORDS = 16384 + 64 * 320;
__device__ __forceinline__ void mx_publish(const Args& a, int wid, int lane, int pm0, int n, unsigned add) {
    asm volatile("s_waitcnt vmcnt(0)" ::: "memory"); __syncthreads();
    if (wid == 0) { if (!WT_STORES) { __builtin_amdgcn_fence(__ATOMIC_RELEASE, "agent"); asm volatile("s_waitcnt vmcnt(0)" ::: "memory"); } if (lane < n) __hip_atomic_fetch_add(ctl_pc(a, pm0 + lane), add, __ATOMIC_RELAXED, __HIP_MEMORY_SCOPE_AGENT); }
}
struct OutDyn {
    unsigned* qh; unsigned* pcb; volatile LAS unsigned* bc; int x;
    __device__ __forceinline__ bool next(int, pg8::Unit& u) const {
        const int lane = threadIdx.x & 63, wid = __builtin_amdgcn_readfirstlane(threadIdx.x >> 6);
        if (wid == 0) { unsigned v = 0u; if (lane == 0) v = __hip_atomic_fetch_add(qh, 1u, __ATOMIC_RELAXED, __HIP_MEMORY_SCOPE_AGENT); v = (unsigned)__builtin_amdgcn_readfirstlane((int)v); if (lane == 0) bc[0] = v; }
        asm volatile("s_waitcnt lgkmcnt(0)" ::: "memory"); __builtin_amdgcn_s_barrier(); asm volatile("" ::: "memory");
        const int t = __builtin_amdgcn_readfirstlane((int)bc[0]);
        asm volatile("s_waitcnt lgkmcnt(0)" ::: "memory"); __builtin_amdgcn_s_barrier(); asm volatile("" ::: "memory");
#ifdef DBL_OUT
        if (t >= 320) return false; const int t_ = t; const int tq = t_ >= 160 ? t_ - 160 : t_;
#define t tq
#else
        if (t >= 160) return false;
#endif
        const int grp = t >> 5, pi = (t & 31) >> 2; int p0;
#if MX_ORDER
        if (grp == 1) p0 = (x >> 1) * 16 + (x & 1) * 8; else { const int sb = grp == 0 ? 0 : grp - 1; p0 = 64 + (4 * x + sb) * 8; }
#else
        if (grp == 2) p0 = (x >> 1) * 16 + (x & 1) * 8; else { const int sb = grp < 2 ? grp : grp - 1; p0 = 64 + (4 * x + sb) * 8; }
#endif
        u.pm = p0 + pi; u.pn = t & 3; return true;
#ifdef DBL_OUT
#undef t
#endif
    }
    __device__ __forceinline__ void a_ready(const pg8::Unit& u) const {
        const int wid = __builtin_amdgcn_readfirstlane(threadIdx.x >> 6);
        if (wid == 0) { unsigned sp = 0; while ((unsigned)__builtin_amdgcn_readfirstlane((int)__hip_atomic_load(pcb + 64 * u.pm, __ATOMIC_RELAXED, __HIP_MEMORY_SCOPE_AGENT)) < 16u) { __builtin_amdgcn_s_sleep(8); if (++sp > (1u << 22)) break; }
            __builtin_amdgcn_fence(__ATOMIC_ACQUIRE, "agent"); asm volatile("s_waitcnt vmcnt(0)" ::: "memory"); }
        asm volatile("s_waitcnt lgkmcnt(0)" ::: "memory"); __builtin_amdgcn_s_barrier(); asm volatile("" ::: "memory");
    }
    __device__ __forceinline__ void done(const pg8::Unit&) const {}
    __device__ __forceinline__ void between(const pg8::Unit&, const pg8::Unit&) const {}
};
__device__ __forceinline__ unsigned* ctl_hg(const Args& a, int g) { return (unsigned*)(a.ws + WS_CTL) + 45056 + 64 * g; }
__device__ __forceinline__ void norm_share(const Args& a, int g, int j) {
    typedef float f4 __attribute__((ext_vector_type(4)));
    const int lane = threadIdx.x & 63, wave = __builtin_amdgcn_readfirstlane(threadIdx.x >> 6);
    const float* mod = (const float*)(a.ws + WS_MOD); bf16* H = (bf16*)(a.ws + WS_H);
    const int nper = j < 8 ? 2 : 10, m0 = 2048 * g + (j < 8 ? 16 * j : 128 + 80 * (j - 8)) + nper * wave, b = batch_of(2048 * g);
    f4 gs[4], sh[4];
#pragma unroll
    for (int q = 0; q < 4; ++q) { const f4 gg = ((const f4*)a.in[4])[lane + 64 * q], sc = ((const f4*)(mod + b * 3072 + 1024))[lane + 64 * q]; gs[q] = gg * (1.f + sc); sh[q] = ((const f4*)(mod + b * 3072))[lane + 64 * q]; }
#pragma unroll
    for (int rb = 0; rb < 12; rb += 4) {
        if (rb >= nper) break;
        f4 v[4][4];
#pragma unroll
        for (int r = 0; r < 4; ++r) { const int m = m0 + (rb + r < nper ? rb + r : nper - 1);
            const float* x = m < NTOK_P ? a.in[0] + (size_t)m * DM : a.in[1] + (size_t)(m - NTOK_P) * DM;
#pragma unroll
            for (int q = 0; q < 4; ++q) v[r][q] = ((const f4*)x)[lane + 64 * q]; }
        __builtin_amdgcn_sched_barrier(0);
#pragma unroll
        for (int r = 0; r < 4; ++r) { const int m = m0 + (rb + r < nper ? rb + r : nper - 1); float s = 0.f;
#pragma unroll
            for (int q = 0; q < 4; ++q) s += (v[r][q][0] * v[r][q][0] + v[r][q][1] * v[r][q][1]) + (v[r][q][2] * v[r][q][2] + v[r][q][3] * v[r][q][3]);
#pragma unroll
            for (int o = 1; o < 64; o <<= 1) s += __shfl_xor(s, o);
            const float rr = rsqrtf(s * (1.f / DM) + EPS);
            unsigned long long* o8 = (unsigned long long*)(H + (size_t)m * DM) + lane;
#pragma unroll
            for (int q = 0; q < 4; ++q) { const f4 y = v[r][q] * rr * gs[q] + sh[q]; __hip_atomic_store(o8 + 64 * q, (unsigned long long)pk2(y[0], y[1]) | ((unsigned long long)pk2(y[2], y[3]) << 32), __ATOMIC_RELAXED, __HIP_MEMORY_SCOPE_AGENT); } }
        __builtin_amdgcn_sched_barrier(0);
    }
    asm volatile("s_waitcnt vmcnt(0)" ::: "memory"); __builtin_amdgcn_s_barrier(); asm volatile("" ::: "memory");
    if (wave == 0 && lane == 0) __hip_atomic_fetch_add(ctl_hg(a, g), 1u, __ATOMIC_RELAXED, __HIP_MEMORY_SCOPE_AGENT);
}
struct InOrder : pg8::StaticOrder {
    const Args* ap; int x, j;
    __device__ __forceinline__ void a_ready(const pg8::Unit& u) const {
        if (u.pn * 8 + (u.pm & 7) >= 32) return;
        const int g = u.pm >> 3; const int wid = __builtin_amdgcn_readfirstlane(threadIdx.x >> 6);
        if (wid == 0) { unsigned sp = 0; while ((unsigned)__builtin_amdgcn_readfirstlane((int)__hip_atomic_load(ctl_hg(*ap, g), __ATOMIC_RELAXED, __HIP_MEMORY_SCOPE_AGENT)) < 32u) { __builtin_amdgcn_s_sleep(4); if (++sp > (1u << 22)) break; }
            __builtin_amdgcn_fence(__ATOMIC_ACQUIRE, "agent"); asm volatile("s_waitcnt vmcnt(0)" ::: "memory"); }
        asm volatile("s_waitcnt lgkmcnt(0)" ::: "memory"); __builtin_amdgcn_s_barrier(); asm volatile("" ::: "memory");
    }
    __device__ __forceinline__ void between(const pg8::Unit& cur, const pg8::Unit& nxt) const {
        const int gc = cur.pm >> 3, gn = nxt.pm >> 3;
        const int i = ((gc - 5 * x) * 104 + cur.pn * 8 + (cur.pm & 7) - j) >> 5;
        int gs = -1;
        if (i == (j & 1)) gs = 5 * x + 1;
        else if (gn != gc && gn + 1 < 5 * (x + 1)) gs = gn + 1;
        if (gs >= 0) norm_share(*ap, gs, j);
    }
};
struct RetBatch { int cg0, h; __device__ __forceinline__ void item(int i, int& cgl, int& hh) const { cgl = cg0 + i; hh = h; } };
#ifdef TSITEM
__device__ unsigned long long mx_out_dummy;
#define MX_OUT_PARAM , unsigned long long& mx_out
#else
#define MX_OUT_PARAM
#endif
__device__ __forceinline__ void mx_phase(const Args& a, char* shm MX_OUT_PARAM) {
    const int lane = threadIdx.x & 63, wid = __builtin_amdgcn_readfirstlane(threadIdx.x >> 6), x = blockIdx.x & 7;
    volatile LAS unsigned* bc = (volatile LAS unsigned*)((LAS unsigned char*)shm + 131072 + 8192);
#ifdef TSITEM
    unsigned long long mx_acc = 0; int mx_cnt = 0, mx_last_kind = 0;
#endif
    const bf16* P = (const bf16*)(a.ws + WS_PROJ); unsigned char* RT = a.ws + WS_RT; bf16* O = (bf16*)(a.ws + WS_MIX);
    const attn_body::bf16* PA = (const attn_body::bf16*)P; attn_body::bf16* OA = (attn_body::bf16*)O;
    for (;;) {
        if (wid == 0) { unsigned v = 0u; if (lane == 0) v = __hip_atomic_fetch_add(ctl_q(a, x), 1u, __ATOMIC_RELAXED, __HIP_MEMORY_SCOPE_AGENT); v = (unsigned)__builtin_amdgcn_readfirstlane((int)v); if (lane == 0) bc[0] = v; }
        __syncthreads();
        const int idx = __builtin_amdgcn_readfirstlane((int)bc[0]);
        __syncthreads();
        if (idx >= MX_LIST) break;
#ifdef TSITEM
        const int kind_ = (idx < 72 && !(idx & 1)) ? ((idx >> 1) < 4 ? 0 : 1) : idx < 100 ? 2 : 3;
        unsigned long long ti0_ = __builtin_amdgcn_s_memrealtime();
#endif
        const bool is_scan = idx < 72 && !(idx & 1); const int si = idx >> 1;
        if (is_scan) {
            int b, h, dir;
            if (si < 4) { b = x >> 1; h = 2 * (x & 1) + (si >> 1); dir = si & 1; } else { const int t = si - 4; b = 4 + 4 * x + (t >> 3); h = (t >> 1) & 3; dir = t & 1; }
            ret_body::scan_item(b, h, dir, P, RT, a.in[8], a.in[9], shm);
#ifdef DBL_SCAN
            ret_body::scan_item(b, h, dir, P, RT, a.in[8], a.in[9], shm);
#endif
            asm volatile("s_waitcnt vmcnt(0)" ::: "memory"); __syncthreads();
            if (wid == 0) { __builtin_amdgcn_fence(__ATOMIC_RELEASE, "agent"); asm volatile("s_waitcnt vmcnt(0)" ::: "memory"); if (lane == 0) __hip_atomic_fetch_add(ctl_sd(a, b, h), 1u, __ATOMIC_RELAXED, __HIP_MEMORY_SCOPE_AGENT); }
        } else if (idx < 100) {
            const int u = idx < 72 ? si : idx - 36, b = x >> 1, kvh = x & 1;
            attn_body::attn_unit<8>((long)b * 4096, 4096, kvh * 4 + (u & 3), u >> 2, (u * 5) & 63, PA, OA, shm);
#ifdef DBL_ATT
            attn_body::attn_unit<8>((long)b * 4096, 4096, kvh * 4 + (u & 3), u >> 2, (u * 5) & 63, PA, OA, shm);
#endif
            mx_publish(a, wid, lane, b * 16 + (u >> 2), 1, 1u);
        } else {
#if MX_ORDER
            const int r = idx - 100; const bool partA = r < 168; const int slot = partA ? (r * 40) / 168 : 0, first = (slot * 168 + 39) / 40;
#else
            const int r = idx - 100; const bool partA = true; const int slot = (r * 40) / 296, first = (slot * 296 + 39) / 40;
#endif
            if (partA && r == first) {
#ifdef TSITEM
                mx_last_kind = 3;
#endif
#ifdef DBG_SKIP_RET
                continue;
#endif
                int b, h, c0;
                if (slot >= 16 && slot < 24) { const int q = slot - 16; b = x >> 1; h = 2 * (x & 1) + (q >> 2); c0 = 8 * (q & 3); }
                else { const int q = slot < 16 ? slot : slot - 8, pr = q >> 1; b = 4 + 4 * x + (pr >> 2); h = pr & 3; c0 = 8 * (q & 1); }
                if (wid == 0) { unsigned sp = 0; while ((unsigned)__builtin_amdgcn_readfirstlane((int)__hip_atomic_load(ctl_sd(a, b, h), __ATOMIC_RELAXED, __HIP_MEMORY_SCOPE_AGENT)) < 2u) { __builtin_amdgcn_s_sleep(8); if (++sp > (1u << 22)) break; }
                    __builtin_amdgcn_fence(__ATOMIC_ACQUIRE, "agent"); asm volatile("s_waitcnt vmcnt(0)" ::: "memory"); }
                __syncthreads();
                const long rowbase = b < 4 ? (long)b * 4096 : (long)NTOK_P + (long)(b - 4) * 2048;
                const RetBatch S{(int)(rowbase >> 7) + c0, h};
                ret_body::retout_phase<RetBatch, 0>(S, 8, P, RT, O, a.in[8], a.in[9], a.in[10], shm);
#ifdef DBL_RETOUT
                ret_body::retout_phase<RetBatch, 0>(S, 8, P, RT, O, a.in[8], a.in[9], a.in[10], shm);
#endif
                mx_publish(a, wid, lane, (int)(rowbase >> 8) + (c0 >> 1), 4, 2u);
            } else {
#ifdef TSITEM
                mx_last_kind = 4;
#endif
                const int v = partA ? r - slot - 1 : r - 40, gi = 8 * x + (v >> 5), j = v & 31, b = gi >> 1, kvh = gi & 1;
                attn_body::attn_unit<8>((long)NTOK_P + (long)b * 2048, 2048, kvh * 4 + (j & 3), j >> 2, (j * 5) & 31, PA, OA, shm);
#ifdef DBL_ATT
                attn_body::attn_unit<8>((long)NTOK_P + (long)b * 2048, 2048, kvh * 4 + (j & 3), j >> 2, (j * 5) & 31, PA, OA, shm);
#endif
                mx_publish(a, wid, lane, 64 + b * 8 + (j >> 2), 1, 1u);
            }
        }
#ifdef TSITEM
        { const unsigned long long d_ = __builtin_amdgcn_s_memrealtime() - ti0_; int k2_ = kind_; if (kind_ == 3) k2_ = mx_last_kind; if (k2_ == TSITEM && mx_cnt == 0) { mx_acc += d_; mx_cnt = 1; } }
#endif
    }
#ifdef TSITEM
    mx_out = mx_acc;
#endif
}
__global__ void __launch_bounds__(NTHREADS, 2) mk_fwd(Args a) {
    extern __shared__ __attribute__((aligned(16))) unsigned char lds_raw[];
    LAS unsigned char* lds = (LAS unsigned char*)lds_raw;
    const int lo = a.ph_lo, hi = a.ph_hi;
#ifdef TSLO
    unsigned long long ts0 = 0, ts1 = 0;
#define TS(k) do { if ((k) == TSLO) ts0 = __builtin_amdgcn_s_memrealtime(); if ((k) == TSHI) ts1 = __builtin_amdgcn_s_memrealtime(); } while (0)
#else
#define TS(k) do {} while (0)
#endif
    TS(0);
    { LAS unsigned* xst = (LAS unsigned*)(lds + LDS_PERSIST); if (threadIdx.x < 2) xst[threadIdx.x] = 0u; }
    __syncthreads();
    XcdBarrier bar = xcd_barrier_post((unsigned*)(a.ws + WS_CTL) + 40960, (volatile LAS unsigned*)(lds + LDS_PERSIST));
#define IN(k) (lo <= (k) && (k) < hi)
#define SEAM(k) do { if (IN(k) && IN((k) + 1)) { xcd_barrier(bar); } } while (0)
    if (IN(0)) { p0_prologue(a, lds); }
    TS(1);
    SEAM(0);
    TS(2);
#if FUSED_NORM
    if (IN(2)) {
        pg8::Gemm g{(const bf16*)(a.ws + WS_H), (const bf16*)(a.ws + WS_WIN), M, INC, DM};
        InOrder S; S.init(M, INC, gridDim.x, (int)blockIdx.x); S.ap = &a; S.x = blockIdx.x & 7; S.j = blockIdx.x >> 3;
        const float* tabR = (const float*)(a.ws + WS_TAB);
        { LAS float* tl = (LAS float*)(lds + 131072); for (int i = threadIdx.x; i < 4096; i += NTHREADS) tl[i] = tabR[i];
          LAS float* ta = (LAS float*)(lds + LDS_TABA); for (int i = threadIdx.x; i < 2048; i += NTHREADS) ta[i] = tabR[4096 + i]; __syncthreads(); }
        norm_share(a, 5 * S.x, S.j);
#ifndef P2F_DEPHASE_TICKS
#define P2F_DEPHASE_TICKS 0
#endif
#if P2F_DEPHASE_TICKS > 0
        if (gridDim.x == 256 && blockIdx.x >= 64) { const unsigned long long t0 = __builtin_amdgcn_s_memrealtime(); const unsigned long long ticks = (unsigned long long)((blockIdx.x >> 3) & 3) * P2F_DEPHASE_TICKS; while (__builtin_amdgcn_s_memrealtime() - t0 < ticks) __builtin_amdgcn_s_sleep(16); }
#endif
        pg8::EpiIn E{(bf16*)(a.ws + WS_PROJ), (const LAS float*)(lds + 131072), (const LAS float*)(lds + LDS_TABA), a.in[11], a.in[12]};
        TS(3);
        pg8::gemm_phase<pg8::EpiIn, InOrder, true, true>(lds, g, S, E);
        TS(4);
#ifdef DBL_P2
        { pg8::StaticOrder S2; S2.init(M, INC, gridDim.x, (int)blockIdx.x); pg8::gemm_phase<pg8::EpiIn, pg8::StaticOrder, true, true>(lds, g, S2, E); }
#endif
    }
#else
    if (IN(1)) { p1_norm(a); }
    SEAM(1);
    if (IN(2)) {
        pg8::Gemm g{(const bf16*)(a.ws + WS_H), (const bf16*)(a.ws + WS_WIN), M, INC, DM}; pg8::StaticOrder S; S.init(M, INC, gridDim.x, (int)blockIdx.x);
        const float* tabR = (const float*)(a.ws + WS_TAB);
        { LAS float* tl = (LAS float*)(lds + 131072); for (int i = threadIdx.x; i < 4096; i += NTHREADS) tl[i] = tabR[i]; __syncthreads(); }
        pg8::EpiIn E{(bf16*)(a.ws + WS_PROJ), (const LAS float*)(lds + 131072), (const LAS float*)(lds + LDS_TABA), a.in[11], a.in[12]};
#ifndef P2_DEPHASE_TICKS
#define P2_DEPHASE_TICKS 875
#endif
        if (P2_DEPHASE_TICKS > 0 && gridDim.x == 256 && blockIdx.x >= 64) { const unsigned long long t0 = __builtin_amdgcn_s_memrealtime(); const unsigned long long ticks = (unsigned long long)((blockIdx.x >> 3) & 3) * P2_DEPHASE_TICKS;
            while (__builtin_amdgcn_s_memrealtime() - t0 < ticks) __builtin_amdgcn_s_sleep(16); }
#ifdef P2_PAD_NOPS
        asm volatile(P2_PAD_NOPS);
#endif
        pg8::gemm_phase<pg8::EpiIn, pg8::StaticOrder, true, true>(lds, g, S, E);
    }
#endif
    SEAM(2);
    TS(5);
#if MERGED_MIX
#ifdef TSITEM
    unsigned long long mxo = 0;
    if (IN(3)) { mx_phase(a, (char*)lds_raw, mxo); }
#else
    if (IN(3)) { mx_phase(a, (char*)lds_raw); }
#endif
    TS(6);
#else
    if (IN(3)) { p3_scan(a, (char*)lds_raw); }
    SEAM(3);
    if (IN(4)) { p4_retout<0>(a, (char*)lds_raw); }
    if (IN(5)) { p5_attn<0, 5>(a, (char*)lds_raw); }
#endif
#if MERGED_MIX && DYN_OUT
    if (IN(6)) {
        pg8::Gemm g{(const bf16*)(a.ws + WS_MIX), (const bf16*)(a.ws + WS_WOUT), M, DM, DM};
        const OutDyn S{ctl_q6(a, blockIdx.x & 7), ctl_pc(a, 0), (volatile LAS unsigned*)(lds + 131072 + 8192), (int)(blockIdx.x & 7)};
        pg8::EpiOut E{a.in[0], a.in[1], (const float*)(a.ws + WS_MOD), a.out};
        pg8::gemm_phase<pg8::EpiOut, OutDyn, true, true>(lds, g, S, E);
    }
    TS(7);
#ifdef TSITEM
    if ((int)blockIdx.x == TSBLOCK) { const unsigned long long d = mxo * TSMUL, t0 = __builtin_amdgcn_s_memrealtime(); while (__builtin_amdgcn_s_memrealtime() - t0 < d) __builtin_amdgcn_s_sleep(32); }
#endif
#ifdef TSLO
    if ((int)blockIdx.x == TSBLOCK) { const unsigned long long d = (ts1 - ts0) * TSMUL, t0 = __builtin_amdgcn_s_memrealtime(); while (__builtin_amdgcn_s_memrealtime() - t0 < d) __builtin_amdgcn_s_sleep(32); }
#endif
#else
    SEAM(5);
    if (IN(6)) {
        pg8::Gemm g{(const bf16*)(a.ws + WS_MIX), (const bf16*)(a.ws + WS_WOUT), M, DM, DM}; pg8::StaticOrder S; S.init(M, DM, gridDim.x, (int)blockIdx.x);
        pg8::EpiOut E{a.in[0], a.in[1], (const float*)(a.ws + WS_MOD), a.out};
#ifdef P6_DEPHASE_TICKS
        { const unsigned long long t0 = __builtin_amdgcn_s_memrealtime(); const unsigned long long ticks = (unsigned long long)((blockIdx.x >> 3) & 3) * P6_DEPHASE_TICKS; while (__builtin_amdgcn_s_memrealtime() - t0 < ticks) __builtin_amdgcn_s_sleep(16); }
#endif
        pg8::gemm_phase<pg8::EpiOut, pg8::StaticOrder, true, true>(lds, g, S, E);
    }
#endif
#undef IN
#undef SEAM
}

__device__ __forceinline__ void p2_plain(const Args& a, LAS unsigned char* lds, int mode) {
    pg8::Gemm g{(const bf16*)(a.ws + WS_H), (const bf16*)(a.ws + WS_WIN), M, INC, DM}; pg8::StaticOrder S; S.init(M, INC, gridDim.x, (int)blockIdx.x);
    pg8::EpiPlain E{(bf16*)(a.ws + WS_PROJ), mode};
    pg8::gemm_phase<pg8::EpiPlain, pg8::StaticOrder, true, true>(lds, g, S, E);
}
__device__ __forceinline__ void p2_real(const Args& a, LAS unsigned char* lds) {
    pg8::Gemm g{(const bf16*)(a.ws + WS_H), (const bf16*)(a.ws + WS_WIN), M, INC, DM}; pg8::StaticOrder S; S.init(M, INC, gridDim.x, (int)blockIdx.x);
    const float* tabR = (const float*)(a.ws + WS_TAB);
    { LAS float* tl = (LAS float*)(lds + 131072); for (int i = threadIdx.x; i < 4096; i += NTHREADS) tl[i] = tabR[i]; __syncthreads(); }
    pg8::EpiIn E{(bf16*)(a.ws + WS_PROJ), (const LAS float*)(lds + 131072), (const LAS float*)(lds + LDS_TABA), a.in[11], a.in[12]};
    pg8::gemm_phase<pg8::EpiIn, pg8::StaticOrder, true, true>(lds, g, S, E);
}
#ifdef PROBE_EXP
__global__ void __launch_bounds__(NTHREADS, 2) mk_probe(Args a) {
    extern __shared__ __attribute__((aligned(16))) unsigned char lds_raw[];
    PROBE_EXP;
}
#endif
extern "C" void kernel_launch(void* const* d_in, const int* in_sizes, int n_in, void* d_out, int out_size, void* d_ws, size_t ws_size, hipStream_t stream) {
    static int grid = 0;
    if (grid == 0) {
        int dev = 0, cus = 0, per_cu = 0;
        hipGetDevice(&dev); hipDeviceGetAttribute(&cus, hipDeviceAttributeMultiprocessorCount, dev);
        hipFuncSetAttribute((const void*)mk_fwd, hipFuncAttributeMaxDynamicSharedMemorySize, LDS_BYTES);
        if (hipOccupancyMaxActiveBlocksPerMultiprocessor(&per_cu, (const void*)mk_fwd, NTHREADS, LDS_BYTES) != hipSuccess || per_cu < 1) {
            fprintf(stderr, "kernel_launch: occupancy query reports %d workgroups per CU; nothing launched\n", per_cu); grid = -1; }
        else if (cus != 256) { fprintf(stderr, "kernel_launch: built for a 256-CU device (8 x 32 work queues); this device reports %d CUs; nothing launched\n", cus); grid = -1; }
        else grid = cus;
        (void)hipGetLastError();
        if (ws_size < WS_END || n_in != 14) { fprintf(stderr, "kernel_launch: workspace too small (%zu < %zu) or n_in %d != 14\n", ws_size, (size_t)WS_END, n_in); grid = -1; }
    }
    if (grid < 0) return;
    Args a{};
    for (int i = 0; i < 14; ++i) a.in[i] = (const float*)d_in[i];
    a.out = (float*)d_out; a.ws = (unsigned char*)d_ws; a.ph_lo = 0; a.ph_hi = 7;
    if (hipMemsetAsync((char*)d_ws + WS_CTL, 0, CTL_ZERO_BYTES, stream) != hipSuccess) { fprintf(stderr, "kernel_launch: memset of the control words failed\n"); return; }
    hipLaunchKernelGGL(mk_fwd, dim3(grid), dim3(NTHREADS), LDS_BYTES, stream, a);
    { const hipError_t e = hipPeekAtLastError(); if (e != hipSuccess) fprintf(stderr, "kernel_launch: launch failed: %s (grid %d)\n", hipGetErrorString(e), grid); }
#ifdef PROBE_EXP
    { hipFuncSetAttribute((const void*)mk_probe, hipFuncAttributeMaxDynamicSharedMemorySize, LDS_BYTES); hipLaunchKernelGGL(mk_probe, dim3(grid), dim3(NTHREADS), LDS_BYTES, stream, a); }
#endif
#ifdef PROBE_PHASE
    hipMemsetAsync((char*)d_ws + WS_CTL, 0, 65536, stream);
    { Args a2 = a; a2.ph_lo = PROBE_PHASE; a2.ph_hi = PROBE_PHASE + 1; hipLaunchKernelGGL(mk_fwd, dim3(grid), dim3(NTHREADS), LDS_BYTES, stream, a2); }
#endif
}
```

```cpp
#include <hip/hip_runtime.h>
#include <cstdio>
#include <cstdint>

#define LAS __attribute__((address_space(3)))
#ifndef DYN_OUT
#define DYN_OUT 1
#endif
#define WT_STORES DYN_OUT
#ifndef TILED_OPERANDS
#define TILED_OPERANDS 1
#endif
#ifndef NT_PROJ
#define NT_PROJ 0
#endif
#ifndef SC1_PROJ
#define SC1_PROJ 0
#endif
typedef unsigned short bf16;
constexpr int DM = 1024, NTOK_P = 4 * 4096, NTOK_S = 32 * 2048, M = NTOK_P + NTOK_S;
constexpr int NB = 36, INC = 3328;
constexpr float EPS = 1e-6f;
constexpr float C2 = 0.125f * 1.4426950408889634f;
constexpr float RK_SCALE = 0.08838834764831845f;
constexpr size_t MiB = 1u << 20;
constexpr size_t WS_CTL = 0, CTL_BYTES = 1 * MiB, CTL_ZERO_BYTES = 256 * 1024;
constexpr size_t WS_MOD = 1 * MiB;
constexpr size_t WS_TAB = 2 * MiB;
constexpr size_t WS_WIN = 4 * MiB;
constexpr size_t WS_WOUT = 12 * MiB;
constexpr size_t WS_H = 16 * MiB;
constexpr size_t WS_MIX = WS_H;
constexpr size_t WS_PROJ = 176 * MiB;
constexpr size_t WS_RT = 696 * MiB;
constexpr size_t WS_END = 856 * MiB;

__host__ __device__ __forceinline__ size_t PG_BASE(int g) { return g < 32 ? (size_t)(g >> 1) * M * 128 + (size_t)(g & 1) * 64 : (size_t)g * M * 64; }
__host__ __device__ __forceinline__ int PG_PITCH(int g) { return g < 32 ? 128 : 64; }
__device__ __forceinline__ unsigned f2bf(float f) { unsigned u = __builtin_bit_cast(unsigned, f); return (u + 0x7fffu + ((u >> 16) & 1u)) >> 16; }
__device__ __forceinline__ unsigned pk2(float lo, float hi) { return f2bf(lo) | (f2bf(hi) << 16); }
__device__ __forceinline__ float bf2f(unsigned short h) { return __builtin_bit_cast(float, (unsigned)h << 16); }
__device__ __forceinline__ float silu(float v) { return v * __builtin_amdgcn_rcpf(1.f + __builtin_amdgcn_exp2f(-1.4426950408889634f * v)); }
__device__ __forceinline__ int batch_of(int m) { return m < NTOK_P ? (m >> 12) : 4 + ((m - NTOK_P) >> 11); }
__device__ __forceinline__ int tpos_of(int m) { return m < NTOK_P ? (m & 4095) : (m & 2047); }
namespace pg8 {
#define PG8_LAS __attribute__((address_space(3)))
typedef unsigned short bf16_t;
typedef short bf16x8 __attribute__((ext_vector_type(8)));
typedef float f32x4 __attribute__((ext_vector_type(4)));
typedef unsigned u32x4 __attribute__((ext_vector_type(4)));
constexpr int BM = 256, BK = 64, HALF = 128, HTB = HALF * BK * 2  , STAGE_BYTES = 8 * HTB, NXCD = 8, WGM = 8;

__host__ __device__ __forceinline__ int lds_byte(int r, int c) { const int st = (r >> 4) * 2 + (c >> 5), rr = r & 15, cc = c & 31, ob = rr * 64 + cc * 2; return st * 1024 + (ob ^ (((ob >> 9) & 1) << 5)); }
__host__ __device__ __forceinline__ void stage_rc(int b, int& R, int& C) { const int st = b / 1024, sb = b % 1024, swz = sb ^ (((sb >> 9) & 1) << 5); R = (st >> 1) * 16 + swz / 64; C = (st & 1) * 32 + (swz % 64) / 2; }
__host__ __device__ __forceinline__ int perm32(int rho) { const int n = rho >> 4, i = rho & 15; return 8 * (i >> 2) + 4 * n + (i & 3); }

__host__ __device__ __forceinline__ size_t tiled_off(int row, int col, int K) { return ((size_t)((row >> 8) * (K >> 6) + (col >> 6)) * 2 + ((row >> 7) & 1)) * (size_t)HTB + (size_t)lds_byte(row & 127, col & 63); }
struct Unit { int pm, pn; };
struct Gemm { const bf16_t* A; const bf16_t* Bt; int M, N, K; };

struct StaticOrder {
    int nM, nN, nwg, G, c;
    __host__ __device__ void init(int M, int N, int G_, int c_) { nM = M / BM; nN = N / BM; nwg = nM * nN; G = G_; c = c_; }
    __host__ __device__ bool next(int i, Unit& u) const {
        const long L = (long)i * G + c; if (L >= nwg) return false;
        int wgid = (int)L; { const int q = nwg / NXCD, r = nwg % NXCD, xcd = wgid % NXCD, off = wgid / NXCD; wgid = (xcd < r ? xcd * (q + 1) : r * (q + 1) + (xcd - r) * q) + off; }
        const int nig = WGM * nN, gid = wgid / nig, fm = gid * WGM, gsz = (nM - fm) < WGM ? (nM - fm) : WGM;
        u.pm = fm + ((wgid % nig) % gsz); u.pn = (wgid % nig) / gsz; return true;
    }
    __device__ __forceinline__ void a_ready(const Unit&) const {}
    __device__ __forceinline__ void done(const Unit&) const {}
    __device__ __forceinline__ void between(const Unit&, const Unit&) const {}
};
__device__ __forceinline__ unsigned cvt_pk_bf16(float lo, float hi) { unsigned r; asm volatile("v_cvt_pk_bf16_f32 %0, %1, %2" : "=v"(r) : "v"(lo), "v"(hi)); return r; }
template <class Epi, class Sched, bool ALIGN_EPI = false, bool SP2 = false>
__device__ __forceinline__ void gemm_phase(PG8_LAS unsigned char* lds, const Gemm g, const Sched& S, const Epi& E) {
    const int tid = threadIdx.x, wid = __builtin_amdgcn_readfirstlane(tid >> 6), lane = tid & 63, wr = wid >> 2, wc = wid & 3, fr = lane & 15, fq = lane >> 4;
    const int K = g.K, nt = K / BK;
    unsigned voffA[2], voffB[2];
#pragma unroll
    for (int i = 0; i < 2; ++i) { int R, C; stage_rc(tid * 16 + i * 8192, R, C); const int Rb = Epi::PERM ? ((R & ~31) + perm32(R & 31)) : R;
        voffA[i] = (unsigned)(R * K + C) * 2u; voffB[i] = (unsigned)(Rb * K + C) * 2u;
#if TILED_OPERANDS
        voffA[i] = voffB[i] = (unsigned)(tid * 16 + i * 8192);
#endif
    }
#if TILED_OPERANDS
    const size_t kstep = 2 * (size_t)HTB;
    const size_t hstep = (size_t)HTB;
#else
    const size_t kstep = (size_t)(BK * 2);
    const size_t hstep = (size_t)HALF * K * 2;
#endif
    const size_t tstep = (size_t)BM * K * 2;
    const unsigned ldsw = (unsigned)wid * 1024u;
    const int aoff = lds_byte(wr * 64 + fr, fq * 8), boff = lds_byte(wc * 32 + fr, fq * 8);
#define PG8_SA(b, h) (((b) * 2 + (h)) * HTB)
#define PG8_SB(b, h) ((4 + (b) * 2 + (h)) * HTB)
#define PG8_STAGE(bufoff, gbase, voff) do { _Pragma("unroll") for (int _i = 0; _i < 2; ++_i) \
        __builtin_amdgcn_global_load_lds((const unsigned*)((const char*)(gbase) + (voff)[_i]), (PG8_LAS unsigned*)(lds + (bufoff) + ldsw + _i * 8192), 16, 0, 0); } while (0)
#define PG8_LDA(dst, b, h) do { _Pragma("unroll") for (int m = 0; m < 4; ++m) _Pragma("unroll") for (int k = 0; k < 2; ++k) dst[m][k] = *(const PG8_LAS bf16x8*)(lds + PG8_SA(b, h) + aoff + m * 2048 + k * 1024); } while (0)
#define PG8_LDB(dst, b, h) do { _Pragma("unroll") for (int n = 0; n < 2; ++n) _Pragma("unroll") for (int k = 0; k < 2; ++k) dst[n][k] = *(const PG8_LAS bf16x8*)(lds + PG8_SB(b, h) + boff + n * 2048 + k * 1024); } while (0)
#define PG8_MMA(ai, bj, At, Bt) do { __builtin_amdgcn_s_setprio(1); _Pragma("unroll") for (int m = 0; m < 4; ++m) _Pragma("unroll") for (int n = 0; n < 2; ++n) _Pragma("unroll") for (int k = 0; k < 2; ++k) \
        acc[ai][bj][m][n] = __builtin_amdgcn_mfma_f32_16x16x32_bf16(Bt[n][k], At[m][k], acc[ai][bj][m][n], 0, 0, 0); __builtin_amdgcn_s_setprio(0); } while (0)
#define PG8_WAIT_V(n) asm volatile("s_waitcnt vmcnt(" #n ")" ::: "memory")
#define PG8_WAIT_L(n) asm volatile("s_waitcnt lgkmcnt(" #n ")" ::: "memory")
#define PG8_BAR __builtin_amdgcn_s_barrier()
#define PG8_SCHED __builtin_amdgcn_sched_barrier(0)
    Unit cur, nxt; int ui = 0;
    if (!S.next(0, cur)) return;
    f32x4 acc[2][2][4][2];
#pragma unroll
    for (int a = 0; a < 2; ++a)
#pragma unroll
        for (int b = 0; b < 2; ++b)
#pragma unroll
            for (int m = 0; m < 4; ++m)
#pragma unroll
                for (int n = 0; n < 2; ++n) acc[a][b][m][n] = (f32x4){0.f, 0.f, 0.f, 0.f};
    bf16x8 At[4][2], B0[2][2], B1[2][2];
    const char* cA = (const char*)g.A + (size_t)cur.pm * tstep; const char* cB = (const char*)g.Bt + (size_t)cur.pn * tstep;
    S.a_ready(cur);
    if constexpr (SP2) {
        PG8_STAGE(PG8_SB(0, 0), cB, voffB); PG8_STAGE(PG8_SB(0, 1), cB + hstep, voffB); PG8_STAGE(PG8_SA(0, 0), cA, voffA); PG8_STAGE(PG8_SA(0, 1), cA + hstep, voffA);
        if (wr == 1) PG8_BAR;
        PG8_WAIT_V(2); PG8_BAR;
        PG8_STAGE(PG8_SB(1, 0), cB + kstep, voffB); PG8_STAGE(PG8_SA(1, 0), cA + kstep, voffA); PG8_STAGE(PG8_SB(1, 1), cB + hstep + kstep, voffB);
        PG8_WAIT_V(6); PG8_BAR;
    } else {
        PG8_STAGE(PG8_SB(0, 0), cB, voffB); PG8_STAGE(PG8_SA(0, 0), cA, voffA); PG8_STAGE(PG8_SB(0, 1), cB + hstep, voffB); PG8_STAGE(PG8_SA(0, 1), cA + hstep, voffA);
        if (wr == 1) PG8_BAR;
        PG8_WAIT_V(4); PG8_BAR;
        PG8_STAGE(PG8_SB(1, 0), cB + kstep, voffB); PG8_STAGE(PG8_SA(1, 0), cA + kstep, voffA); PG8_STAGE(PG8_SB(1, 1), cB + hstep + kstep, voffB);
        PG8_WAIT_V(6); PG8_BAR;
    }
    for (;;) {
        const bool has_next = S.next(ui + 1, nxt);
        const char* nA = has_next ? (const char*)g.A + (size_t)nxt.pm * tstep : cA; const char* nB = has_next ? (const char*)g.Bt + (size_t)nxt.pn * tstep : cB;
        if constexpr (Epi::PREFETCH) E.prefetch(cur, lds, wid, lane);
#ifdef GEMM_LOOP_ALIGN
        asm volatile(GEMM_LOOP_ALIGN ::: "memory");
#endif
        for (int t = 0; t < nt; t += 2) {
            const bool last = (t == nt - 2);
            const char* a1 = cA + (size_t)(t + 1) * kstep;
            const char* a2 = last ? nA : cA + (size_t)(t + 2) * kstep; const char* b2 = last ? nB : cB + (size_t)(t + 2) * kstep;
            const char* a3 = a2 + kstep; const char* b3 = b2 + kstep;
            if (last && has_next) S.a_ready(nxt);
            if constexpr (SP2) {
            PG8_LDB(B0, 0, 0); PG8_LDB(B1, 0, 1); PG8_SCHED; PG8_LDA(At, 0, 0); PG8_STAGE(PG8_SA(1, 1), a1 + hstep, voffA);
            PG8_WAIT_V(8); PG8_WAIT_L(0); PG8_BAR; PG8_MMA(0, 0, At, B0); PG8_MMA(0, 1, At, B1); PG8_BAR; PG8_SCHED;
            PG8_LDA(At, 0, 1); PG8_STAGE(PG8_SB(0, 0), b2, voffB); PG8_STAGE(PG8_SB(0, 1), b2 + hstep, voffB); PG8_STAGE(PG8_SA(0, 0), a2, voffA);
            PG8_WAIT_V(8); PG8_WAIT_L(0); PG8_BAR; PG8_MMA(1, 0, At, B0); PG8_MMA(1, 1, At, B1); PG8_BAR; PG8_SCHED;
            PG8_LDB(B0, 1, 0); PG8_LDB(B1, 1, 1); PG8_SCHED; PG8_LDA(At, 1, 0); PG8_STAGE(PG8_SA(0, 1), a2 + hstep, voffA);
            PG8_WAIT_V(8); PG8_WAIT_L(0); PG8_BAR; PG8_MMA(0, 0, At, B0); PG8_MMA(0, 1, At, B1); PG8_BAR; PG8_SCHED;
            PG8_LDA(At, 1, 1); PG8_STAGE(PG8_SB(1, 0), b3, voffB); PG8_STAGE(PG8_SB(1, 1), b3 + hstep, voffB); PG8_STAGE(PG8_SA(1, 0), a3, voffA);
            PG8_WAIT_V(8); PG8_WAIT_L(0); PG8_BAR; PG8_MMA(1, 0, At, B0); PG8_MMA(1, 1, At, B1); PG8_BAR; PG8_SCHED;
            } else {
            PG8_LDB(B0, 0, 0); PG8_SCHED; PG8_LDA(At, 0, 0); PG8_STAGE(PG8_SA(1, 1), a1 + hstep, voffA);
            PG8_WAIT_L(8); PG8_BAR; PG8_WAIT_L(0); PG8_MMA(0, 0, At, B0); PG8_BAR; PG8_SCHED;
            PG8_LDB(B1, 0, 1); PG8_STAGE(PG8_SB(0, 0), b2, voffB);
            PG8_BAR; PG8_WAIT_L(0); PG8_MMA(0, 1, At, B1); PG8_BAR;
            PG8_LDA(At, 0, 1); PG8_STAGE(PG8_SA(0, 0), a2, voffA);
            PG8_BAR; PG8_WAIT_L(0); PG8_MMA(1, 0, At, B0); PG8_BAR; PG8_SCHED;
            PG8_STAGE(PG8_SB(0, 1), b2 + hstep, voffB);
            PG8_WAIT_V(6); PG8_BAR; PG8_MMA(1, 1, At, B1); PG8_BAR;
            PG8_LDB(B0, 1, 0); PG8_SCHED; PG8_LDA(At, 1, 0); PG8_STAGE(PG8_SA(0, 1), a2 + hstep, voffA);
            PG8_WAIT_L(8); PG8_BAR; PG8_WAIT_L(0); PG8_MMA(0, 0, At, B0); PG8_BAR; PG8_SCHED;
            PG8_LDB(B1, 1, 1); PG8_STAGE(PG8_SB(1, 0), b3, voffB);
            PG8_BAR; PG8_WAIT_L(0); PG8_MMA(0, 1, At, B1); PG8_BAR;
            PG8_LDA(At, 1, 1); PG8_STAGE(PG8_SA(1, 0), a3, voffA);
            PG8_BAR; PG8_WAIT_L(0); PG8_MMA(1, 0, At, B0); PG8_BAR; PG8_SCHED;
            PG8_STAGE(PG8_SB(1, 1), b3 + hstep, voffB);
            PG8_WAIT_V(6); PG8_BAR; PG8_MMA(1, 1, At, B1); PG8_BAR;
            }
        }
        if constexpr (ALIGN_EPI) { if (wr == 0) PG8_BAR; }
        if constexpr (!Epi::AFTER_DRAIN) { E(acc, cur, wr, wc, fr, fq); S.done(cur); }
        if constexpr (ALIGN_EPI) { if (has_next) S.between(cur, nxt); }
        if (!has_next) break;
#pragma unroll
        for (int a = 0; a < 2; ++a)
#pragma unroll
            for (int b = 0; b < 2; ++b)
#pragma unroll
                for (int m = 0; m < 4; ++m)
#pragma unroll
                    for (int n = 0; n < 2; ++n) acc[a][b][m][n] = (f32x4){0.f, 0.f, 0.f, 0.f};
        cur = nxt; cA = nA; cB = nB; ++ui;
        if constexpr (ALIGN_EPI) { if (wr == 1) PG8_BAR; }
    }
    PG8_WAIT_V(0);
    if constexpr (!ALIGN_EPI) { if (wr == 0) PG8_BAR; }
    PG8_BAR;
    if constexpr (Epi::AFTER_DRAIN) { E.fused(acc, cur, wr, wc, fr, fq, lds, wid, lane); S.done(cur); }
#undef PG8_SA
#undef PG8_SB
#undef PG8_STAGE
#undef PG8_LDA
#undef PG8_LDB
#undef PG8_MMA
#undef PG8_WAIT_V
#undef PG8_WAIT_L
#undef PG8_BAR
#undef PG8_SCHED
}
}
namespace pg8 {
typedef unsigned u32x2 __attribute__((ext_vector_type(2)));
__device__ __forceinline__ f32x4 silu4(f32x4 v) { f32x4 o; o[0] = silu(v[0]); o[1] = silu(v[1]); o[2] = silu(v[2]); o[3] = silu(v[3]); return o; }
__host__ __device__ __forceinline__ bool in_is_att(int g) { return g >= 32 && g < 42; }
__host__ __device__ __forceinline__ int in_physrow(int Lc) {
    const int g = Lc >> 6, d = Lc & 63; int bj, fq; const int n = (d >> 2) & 1, j = d & 3;
    if (in_is_att(g)) { bj = (d >> 4) & 1; fq = 2 * (d >> 5) + ((d >> 3) & 1); } else { bj = d >> 5; fq = (d >> 3) & 3; }
    return (Lc >> 8) * 256 + 128 * bj + 32 * (g & 3) + 16 * n + 4 * fq + j;
}
struct EpiIn {
    static constexpr bool PERM = false, AFTER_DRAIN = false, PREFETCH = false;
    bf16_t* P; const PG8_LAS float* tabR; const PG8_LAS float* tabA; const float* qng; const float* kng;
    __device__ __forceinline__ static void st16(bf16_t* p, const f32x4& a, const f32x4& b) { u32x4 w; w.x = cvt_pk_bf16(a[0], a[1]); w.y = cvt_pk_bf16(a[2], a[3]); w.z = cvt_pk_bf16(b[0], b[1]); w.w = cvt_pk_bf16(b[2], b[3]);
#if SC1_PROJ
        asm volatile("global_store_dwordx4 %0, %1, off sc1\n\ts_nop 1" :: "v"(p), "v"(w) : "memory");
#elif NT_PROJ
        __builtin_nontemporal_store(w, (u32x4*)p);
#else
        *(u32x4*)p = w;
#endif
    }
    __device__ __forceinline__ void operator()(const f32x4 (&acc)[2][2][4][2], const Unit& u, int wr, int wc, int fr, int fq) const {
        const int g = u.pn * 4 + wc; const size_t gbase = PG_BASE(g); const int gpitch = PG_PITCH(g);
        const int rowb = u.pm * BM + wr * 64 + fr, tb = tpos_of(u.pm * BM);
        const bool img = g < 32, tsty = g >= 16 && g < 24; const size_t ibase = (size_t)(g >> 1) * M * 128 + (tsty ? (size_t)(2 * (g & 1)) * 4096 + 8 * fq : (size_t)(8 * (g & 1) + fq) * 1024);
        if (g < 16) {
            const float sc = (g >= 8) ? RK_SCALE : 1.f;
#define EPI_ROPE_ROW(ai, m) do { const int row_ = rowb + (ai) * HALF + (m) * 16; bf16_t* out = img ? P + ibase + (size_t)(row_ >> 7) * 16384 + (row_ & 127) * 8 : P + gbase + (size_t)row_ * gpitch + 8 * fq; f32x4 y[2][2]; \
                _Pragma("unroll") for (int n = 0; n < 2; ++n) { const f32x4 x1 = acc[ai][0][m][n], x2 = acc[ai][1][m][n]; y[0][n] = (x1 * c[n] - x2 * sn[n]) * sc; y[1][n] = (x2 * c[n] + x1 * sn[n]) * sc; } \
                st16(out, y[0][0], y[0][1]); st16(out + (img ? 4096 : 32), y[1][0], y[1][1]); } while (0)
#define EPI_ROPE_TAB(pos) f32x4 c[2], sn[2]; _Pragma("unroll") for (int n = 0; n < 2; ++n) { c[n] = *(const PG8_LAS f32x4*)(tabR + (pos) * 32 + 8 * fq + 4 * n); sn[n] = *(const PG8_LAS f32x4*)(tabR + 2048 + (pos) * 32 + 8 * fq + 4 * n); }
            if (g & 1) {
#pragma unroll
                for (int m = 0; m < 4; ++m) { EPI_ROPE_TAB(16 * m + fr)
#pragma unroll
                    for (int ai = 0; ai < 2; ++ai) EPI_ROPE_ROW(ai, m); }
            } else {
#pragma unroll
                for (int ai = 0; ai < 2; ++ai) { EPI_ROPE_TAB((tb >> 6) + 2 * ai + wr)
#pragma unroll
                    for (int m = 0; m < 4; ++m) EPI_ROPE_ROW(ai, m); }
            }
#undef EPI_ROPE_ROW
#undef EPI_ROPE_TAB
        } else if (in_is_att(g)) {
            const int H = fq >> 1, F = fq & 1; const float* gw = (g < 40) ? qng : kng; const float sc = (g < 40) ? C2 : 1.f;
            f32x4 w[2][2];
#pragma unroll
            for (int bj = 0; bj < 2; ++bj)
#pragma unroll
                for (int n = 0; n < 2; ++n) w[bj][n] = *(const f32x4*)(gw + 32 * H + 8 * F + 16 * bj + 4 * n);
#pragma unroll
            for (int ai = 0; ai < 2; ++ai)
#pragma unroll
                for (int m = 0; m < 4; ++m) {
                    const int pos = H ? (16 * m + fr) : ((tb >> 6) + 2 * ai + wr);
                    float ss = 0.f;
#pragma unroll
                    for (int bj = 0; bj < 2; ++bj)
#pragma unroll
                        for (int n = 0; n < 2; ++n) { const f32x4 x = acc[ai][bj][m][n]; ss += (x[0] * x[0] + x[1] * x[1]) + (x[2] * x[2] + x[3] * x[3]); }
                    ss += __shfl_xor(ss, 16); ss += __shfl_xor(ss, 32);
                    const float rn = rsqrtf(ss * (1.f / 64.f) + EPS);
                    const int row_ = rowb + ai * HALF + m * 16;
                    bf16_t* out = g >= 40 ? P + gbase + (size_t)(row_ >> 6) * 4096 + (4 * H + F) * 512 + (row_ & 63) * 8 : P + gbase + (size_t)row_ * gpitch + 32 * H + 8 * F;
                    f32x4 y[2][2];
#pragma unroll
                    for (int n = 0; n < 2; ++n) { const f32x4 c = *(const PG8_LAS f32x4*)(tabA + pos * 16 + 8 * F + 4 * n), sn = *(const PG8_LAS f32x4*)(tabA + 1024 + pos * 16 + 8 * F + 4 * n);
                        const f32x4 x1 = acc[ai][0][m][n] * rn * w[0][n], x2 = acc[ai][1][m][n] * rn * w[1][n]; y[0][n] = (x1 * c - x2 * sn) * sc; y[1][n] = (x2 * c + x1 * sn) * sc; }
                    st16(out, y[0][0], y[0][1]); st16(out + (g >= 40 ? 1024 : 16), y[1][0], y[1][1]); }
        } else {
            const bool act = (g >= 24 && g < 32) || g >= 44;
#pragma unroll
            for (int ai = 0; ai < 2; ++ai)
#pragma unroll
                for (int m = 0; m < 4; ++m) { const int row_ = rowb + ai * HALF + m * 16; const bool av = g == 42 || g == 43;
                    bf16_t* out = img ? P + ibase + (size_t)(row_ >> 7) * 16384 + (tsty ? ((row_ & 127) >> 4) * 512 + (row_ & 15) * 32 : (row_ & 127) * 8) : av ? P + gbase + (size_t)(row_ >> 6) * 4096 + (row_ & 63) * 32 + 8 * fq : P + gbase + (size_t)row_ * gpitch + 8 * fq;
#pragma unroll
                    for (int bj = 0; bj < 2; ++bj) { f32x4 a0 = acc[ai][bj][m][0], a1 = acc[ai][bj][m][1]; if (act) { a0 = silu4(a0); a1 = silu4(a1); } st16(out + (img ? 4096 : av ? 2048 : 32) * bj, a0, a1); } }
        }
    }
};
struct EpiPlain {
    static constexpr bool PERM = false, AFTER_DRAIN = false, PREFETCH = false;
    bf16_t* P; int mode;
    __device__ __forceinline__ void operator()(const f32x4 (&acc)[2][2][4][2], const Unit& u, int wr, int wc, int fr, int fq) const {
        const int g = u.pn * 4 + wc; const size_t gbase = PG_BASE(g); const int gpitch = PG_PITCH(g); const int rowb = u.pm * BM + wr * 64 + fr;
#pragma unroll
        for (int ai = 0; ai < 2; ++ai)
#pragma unroll
            for (int m = 0; m < 4; ++m) { bf16_t* out = P + gbase + (size_t)(rowb + ai * HALF + m * 16) * gpitch + 8 * fq;
#pragma unroll
                for (int bj = 0; bj < 2; ++bj) { if (mode == 0) EpiIn::st16(out + 32 * bj, acc[ai][bj][m][0], acc[ai][bj][m][1]); else asm volatile("" :: "v"(acc[ai][bj][m][0]), "v"(acc[ai][bj][m][1])); } }
    }
};
#ifndef EPIOUT_NT
#define EPIOUT_NT 0
#endif
#if EPIOUT_NT
#define EPIOUT_LD(p) __builtin_nontemporal_load(p)
#define EPIOUT_ST(v, p) __builtin_nontemporal_store(v, p)
#else
#define EPIOUT_LD(p) (*(p))
#define EPIOUT_ST(v, p) (*(p) = (v))
#endif
struct EpiOut {
    static constexpr bool PERM = false, AFTER_DRAIN = false;
#ifndef X_PREFETCH
    static constexpr bool PREFETCH = false;
#else
    static constexpr bool PREFETCH = true;
#endif
    const float* xp; const float* xs; const float* mod; float* y;
    __device__ __forceinline__ void prefetch(const Unit& u, PG8_LAS unsigned char* lds, int wid, int lane) const {
        const int row0 = u.pm * BM; const float* xb = (row0 < NTOK_P ? xp + (size_t)row0 * DM : xs + (size_t)(row0 - NTOK_P) * DM) + u.pn * BM;
#pragma unroll
        for (int i = 0; i < 4; ++i) { const int L = (wid * 4 + i) * 64 + lane;
            __builtin_amdgcn_global_load_lds((const unsigned*)(xb + (size_t)(L >> 3) * DM + (L & 7) * 32), (PG8_LAS unsigned*)(lds + 131072 + 4096 + wid * 256), 4, 0, 0); }
    }
    __device__ __forceinline__ void operator()(const f32x4 (&acc)[2][2][4][2], const Unit& u, int wr, int wc, int fr, int fq) const {
        const int row0 = u.pm * BM, b = batch_of(row0); const float* __restrict__ gate = mod + b * 3072 + 2048;
        const float* __restrict__ xb = (row0 < NTOK_P ? xp + (size_t)row0 * DM : xs + (size_t)(row0 - NTOK_P) * DM) + u.pn * BM + wc * 32 + 4 * fq;
        float* __restrict__ yb = y + (size_t)row0 * DM + u.pn * BM + wc * 32 + 4 * fq;
        f32x4 gv[2][2];
#pragma unroll
        for (int bj = 0; bj < 2; ++bj)
#pragma unroll
            for (int n = 0; n < 2; ++n) gv[bj][n] = *(const f32x4*)(gate + u.pn * BM + bj * HALF + wc * 32 + 16 * n + 4 * fq);
#define EPO_ADDR(ai, m, bj, n) ((size_t)((ai) * HALF + wr * 64 + (m) * 16 + fr) * DM + (bj) * HALF + 16 * (n))
        f32x4 x0[4][2][2], x1[4][2][2];
#pragma unroll
        for (int m = 0; m < 4; ++m)
#pragma unroll
            for (int bj = 0; bj < 2; ++bj)
#pragma unroll
                for (int n = 0; n < 2; ++n) x0[m][bj][n] = EPIOUT_LD((const f32x4*)(xb + EPO_ADDR(0, m, bj, n)));
        __builtin_amdgcn_sched_barrier(0);
#pragma unroll
        for (int m = 0; m < 4; ++m)
#pragma unroll
            for (int bj = 0; bj < 2; ++bj)
#pragma unroll
                for (int n = 0; n < 2; ++n) x0[m][bj][n] = x0[m][bj][n] + gv[bj][n] * acc[0][bj][m][n];
        __builtin_amdgcn_sched_barrier(0);
#pragma unroll
        for (int m = 0; m < 4; ++m)
#pragma unroll
            for (int bj = 0; bj < 2; ++bj)
#pragma unroll
                for (int n = 0; n < 2; ++n) x1[m][bj][n] = EPIOUT_LD((const f32x4*)(xb + EPO_ADDR(1, m, bj, n)));
        __builtin_amdgcn_sched_barrier(0);
#pragma unroll
        for (int m = 0; m < 4; ++m)
#pragma unroll
            for (int bj = 0; bj < 2; ++bj)
#pragma unroll
                for (int n = 0; n < 2; ++n) EPIOUT_ST(x0[m][bj][n], (f32x4*)(yb + EPO_ADDR(0, m, bj, n)));
        __builtin_amdgcn_sched_barrier(0);
#pragma unroll
        for (int m = 0; m < 4; ++m)
#pragma unroll
            for (int bj = 0; bj < 2; ++bj)
#pragma unroll
                for (int n = 0; n < 2; ++n) EPIOUT_ST(x1[m][bj][n] + gv[bj][n] * acc[1][bj][m][n], (f32x4*)(yb + EPO_ADDR(1, m, bj, n)));
#undef EPO_ADDR
    }
};
}
#include <hip/hip_bf16.h>
#include <cmath>
namespace attn_body {
using bf16=__hip_bfloat16;
using bf16x8=__attribute__((ext_vector_type(8)))short;
using s16x4=__attribute__((ext_vector_type(4)))short;
using f32x16=__attribute__((ext_vector_type(16)))float;
using u32x4=__attribute__((ext_vector_type(4)))unsigned;
constexpr int D=64,DM=64,OPITCH=1024; constexpr long GSZ=(long)81920*64;
constexpr int NW=8,QBLK=32,QB=QBLK*NW,KVBLK=64;
constexpr int ATTN_PITCH=DM, ATTN_UNIT_ROWS=QB;
__device__ __forceinline__ int crow(int r,int hi){return (r&3)+8*(r>>2)+4*hi;}
#define SBAR() __builtin_amdgcn_sched_barrier(0)
__device__ __forceinline__ void cmask(f32x16&p0,f32x16&p1,int jb,int qrel,int hi){
  const float NEG=-INFINITY; int kb=64*jb+4*hi;
  #pragma unroll
  for(int r=0;r<16;++r){int kv=kb+(r&3)+8*(r>>2); if(kv>qrel)p0[r]=NEG; if(kv+32>qrel)p1[r]=NEG;}
}

constexpr int NSLOT=3, SLOTB=8192;
constexpr int LDS_K=0, LDS_V=NSLOT*SLOTB, LDS_WS=2*NSLOT*SLOTB, LDS_OST=LDS_WS+NW*64*4, LDS_GATE=LDS_OST+NW*4096, LDS_BYTES=LDS_GATE+NW*4096;
constexpr float C2=0.125f*1.4426950408889634f;
__device__ __forceinline__ void glds16(const void*gsrc,unsigned lds_dst){unsigned keep;
  asm volatile("s_mov_b32 %0, m0\n\ts_mov_b32 m0, %2\n\ts_nop 0\n\tglobal_load_lds_dwordx4 %1, off\n\ts_mov_b32 m0, %0":"=&s"(keep):"v"(gsrc),"s"(lds_dst):"memory");}
__device__ __forceinline__ float max3f(float a,float b,float c){float r;asm("v_max3_f32 %0, %1, %2, %3":"=v"(r):"v"(a),"v"(b),"v"(c));return r;}
__device__ __forceinline__ float max2f(float a,float b){float r;asm("v_max_f32_e32 %0, %1, %2":"=v"(r):"v"(a),"v"(b));return r;}
__device__ __forceinline__ float fadd_s(float a,float b){float r;asm("v_add_f32_e32 %0, %1, %2":"=v"(r):"v"(a),"v"(b));return r;}
__device__ __forceinline__ float fsub_s(float a,float b){float r;asm("v_sub_f32_e32 %0, %1, %2":"=v"(r):"v"(a),"v"(b));return r;}
typedef float f32x2_t __attribute__((ext_vector_type(2))); typedef __bf16 bf16x2_t __attribute__((ext_vector_type(2)));
__device__ __forceinline__ unsigned cvtpk_s(float lo,float hi){f32x2_t v={lo,hi};bf16x2_t b=__builtin_convertvector(v,bf16x2_t);return __builtin_bit_cast(unsigned,b);}
#define WAIT_BAR(N) asm volatile("s_waitcnt vmcnt(" #N ") lgkmcnt(0)\n\ts_barrier":::"memory")

__device__ __forceinline__ void qkt(f32x16&p0,f32x16&p1,const char*Kslot,const bf16x8*qr,const f32x16&negm,int r32,int hi){
  const char*kb=Kslot+hi*1024+r32*16;
  #pragma unroll
  for(int d0=0;d0<4;++d0){
    const bf16x8 b0=*reinterpret_cast<const bf16x8*>(kb+d0*2048);
    const bf16x8 b1=*reinterpret_cast<const bf16x8*>(kb+d0*2048+512);
    if(d0==0){p0=__builtin_amdgcn_mfma_f32_32x32x16_bf16(b0,qr[0],negm,0,0,0);p1=__builtin_amdgcn_mfma_f32_32x32x16_bf16(b1,qr[0],negm,0,0,0);}
    else{p0=__builtin_amdgcn_mfma_f32_32x32x16_bf16(b0,qr[d0],p0,0,0,0);p1=__builtin_amdgcn_mfma_f32_32x32x16_bf16(b1,qr[d0],p1,0,0,0);}}
}
typedef __attribute__((address_space(3))) const char* lds_cptr;
typedef short v4i16_t __attribute__((ext_vector_type(4)));
__device__ __forceinline__ void kload8(bf16x8*kf,lds_cptr kp){
  kf[0]=*(const __attribute__((address_space(3))) bf16x8*)(kp);      kf[1]=*(const __attribute__((address_space(3))) bf16x8*)(kp+512);
  kf[2]=*(const __attribute__((address_space(3))) bf16x8*)(kp+2048); kf[3]=*(const __attribute__((address_space(3))) bf16x8*)(kp+2560);
  kf[4]=*(const __attribute__((address_space(3))) bf16x8*)(kp+4096); kf[5]=*(const __attribute__((address_space(3))) bf16x8*)(kp+4608);
  kf[6]=*(const __attribute__((address_space(3))) bf16x8*)(kp+6144); kf[7]=*(const __attribute__((address_space(3))) bf16x8*)(kp+6656);
}
__device__ __forceinline__ void kload2(bf16x8*kf,lds_cptr kp,int j){ kf[2*j]=*(const __attribute__((address_space(3))) bf16x8*)(kp+j*2048); kf[2*j+1]=*(const __attribute__((address_space(3))) bf16x8*)(kp+j*2048+512); }
__device__ __forceinline__ s16x4 vtr(lds_cptr p){ return __builtin_bit_cast(s16x4,__builtin_amdgcn_ds_read_tr16_b64_v4i16((__attribute__((address_space(3))) v4i16_t*)p)); }
__device__ __forceinline__ float rowmax(const f32x16&p0,const f32x16&p1){
  float a=max3f(p0[0],p0[1],p1[0]),b=max3f(p0[2],p0[3],p1[1]);a=max3f(a,p1[2],p1[3]);
  #pragma unroll
  for(int r=4;r<16;r+=4){a=max3f(a,p0[r],p0[r+1]);b=max3f(b,p0[r+2],p0[r+3]);a=max3f(a,p1[r],p1[r+1]);b=max3f(b,p1[r+2],p1[r+3]);}
  const float m=max2f(a,b);
  auto rr=__builtin_amdgcn_permlane32_swap(__float_as_uint(m),__float_as_uint(m),false,false);
  return max2f(__uint_as_float(rr[0]),__uint_as_float(rr[1]));
}
__device__ __forceinline__ void pv(f32x16*o,int vb,bf16x8 pa0,bf16x8 pa1,bf16x8 pa2,bf16x8 pa3){
  #pragma unroll
  for(int d0=0;d0<2;++d0){s16x4 lo[4],hi[4];
    #pragma unroll
    for(int ks=0;ks<4;++ks){
      asm volatile("ds_read_b64_tr_b16 %0,%1 offset:%c2":"=&v"(lo[ks]):"v"(vb),"i"(d0*4096+ks*1024):"memory");
      asm volatile("ds_read_b64_tr_b16 %0,%1 offset:%c2":"=&v"(hi[ks]):"v"(vb),"i"(d0*4096+ks*1024+512):"memory");}
    asm volatile("s_waitcnt lgkmcnt(0)":::"memory");SBAR();
    #define PK(k) (bf16x8){lo[k][0],lo[k][1],lo[k][2],lo[k][3],hi[k][0],hi[k][1],hi[k][2],hi[k][3]}
    o[d0]=__builtin_amdgcn_mfma_f32_32x32x16_bf16(pa0,PK(0),o[d0],0,0,0);
    o[d0]=__builtin_amdgcn_mfma_f32_32x32x16_bf16(pa1,PK(1),o[d0],0,0,0);
    o[d0]=__builtin_amdgcn_mfma_f32_32x32x16_bf16(pa2,PK(2),o[d0],0,0,0);
    o[d0]=__builtin_amdgcn_mfma_f32_32x32x16_bf16(pa3,PK(3),o[d0],0,0,0);
    #undef PK
  }
}

__device__ __forceinline__ void store16_sc1(void*p,u32x4 v){ asm volatile("global_store_dwordx4 %0, %1, off sc1\n\ts_nop 1"::"v"(p),"v"(v):"memory"); }
#ifndef ATTN_STORE16
#if WT_STORES
#define ATTN_STORE16(p,v) store16_sc1((void*)(p),(v))
#else
#define ATTN_STORE16(p,v) (*(u32x4*)(p)=(v))
#endif
#endif
#ifndef ATTN_STORE16_X
#define ATTN_STORE16_X(p,v) (*(u32x4*)(p)=(v))
#endif
template<int THRL> __device__ __forceinline__ void attn_unit(long rowbase,int S,int h,int qb,int t0,const bf16*__restrict__ P,bf16*O,char*shm){
  int tid=threadIdx.x; asm volatile("":"+v"(tid));
  const int lane=tid&63,r32=lane&31,hi=lane>>5; const int wid=__builtin_amdgcn_readfirstlane(tid>>6);
  const int q0=qb*QB;
  const bf16*Qw=P+(32+h)*GSZ+(rowbase+q0+wid*QBLK)*DM;
  const bf16*Kh=P+(40+(h>>2))*GSZ+rowbase*DM,*Vh=P+(42+(h>>2))*GSZ+rowbase*DM;
  const unsigned lds0=(unsigned)(uintptr_t)shm;
  float*wsf=(float*)(shm+LDS_WS)+wid*64;
  const bf16*ksrc=Kh+wid*512+lane*8;
  const bf16*vsrc=Vh+wid*512+lane*8;
  const unsigned kdst=lds0+LDS_K+wid*1024, vdst=lds0+LDS_V+wid*1024;
  #define DMA_K(t,slot) glds16(ksrc+(long)(((t)+t0)&(NT-1))*KVBLK*DM,(unsigned)__builtin_amdgcn_readfirstlane(kdst+(slot)))
  #define DMA_V(t,slot) glds16(vsrc+(long)(((t)+t0)&(NT-1))*KVBLK*DM,(unsigned)__builtin_amdgcn_readfirstlane(vdst+(slot)))
  const int vb0=(int)(lds0+LDS_V)+((lane>>4)&1)*32+(lane&3)*8+(4*hi+((lane&15)>>2))*64;
  const char*Kbase=shm+LDS_K; bf16x8 kf[8];
  const lds_cptr shm3=(lds_cptr)shm; const lds_cptr kp0=shm3+LDS_K+hi*1024+r32*16; const lds_cptr vp0=shm3+LDS_V+((lane>>4)&1)*32+(lane&3)*8+(4*hi+((lane&15)>>2))*64;
  const int NT=S/KVBLK;
  { const bf16*Gw_=P+(44+h)*GSZ+(rowbase+q0+wid*QBLK)*DM+lane*8;
    _Pragma("unroll") for(int i=0;i<4;++i) glds16(Gw_+i*512,(unsigned)__builtin_amdgcn_readfirstlane(lds0+LDS_GATE+wid*4096+i*1024)); }
  DMA_K(0,0);DMA_V(0,0);DMA_K(1,SLOTB);
  bf16x8 qr[4];
  #pragma unroll
  for(int d0=0;d0<4;++d0)qr[d0]=*reinterpret_cast<const bf16x8*>(&Qw[(long)r32*DM+d0*16+hi*8]);
  float mhat=0.f,l_reg=0.f;f32x16 o[2];o[0]=f32x16{};o[1]=f32x16{};f32x16 negm=f32x16{};asm volatile("":"+v"(negm));
  #define CMASK(P0,P1,t) do{}while(0)
  bool resc=false;
  #define START(P0,P1) do{ const float rm=rowmax(P0,P1); resc=false; \
    { const float dl=rm; mhat=fadd_s(mhat,dl); \
      _Pragma("unroll") for(int r=0;r<16;++r){P0[r]=fsub_s(P0[r],dl);P1[r]=fsub_s(P1[r],dl);} \
      _Pragma("unroll") for(int r=0;r<16;++r)negm[r]=-mhat; asm volatile("":"+v"(negm)); } \
    _Pragma("unroll") for(int r=0;r<16;++r)P0[r]=__builtin_amdgcn_exp2f(P0[r]); }while(0)
  #define RESC() do{ if(resc){ asm volatile("s_waitcnt lgkmcnt(0)":::"memory"); \
      _Pragma("unroll") for(int d_=0;d_<2;++d_) _Pragma("unroll") for(int r=0;r<16;++r)o[d_][r]*=wsf[crow(r,hi)]; } }while(0)
  f32x16 pA0,pA1,pB0,pB1;
  int sl_prev=0,sl_cur=0,sl_next=SLOTB;
  #define ROT() do{sl_prev=sl_cur;sl_cur=sl_next;sl_next=(sl_next==(NSLOT-1)*SLOTB)?0:sl_next+SLOTB;}while(0)
  DMA_K(2,2*SLOTB);
  WAIT_BAR(3);
  qkt(pA0,pA1,Kbase,qr,negm,r32,hi);asm volatile("s_nop 15\n\ts_nop 7":"+v"(pA0),"+v"(pA1));CMASK(pA0,pA1,0);
  START(pA0,pA1);
  _Pragma("unroll") for(int r=0;r<16;++r)pA1[r]=__builtin_amdgcn_exp2f(pA1[r]);
  WAIT_BAR(0);
  DMA_K(3,0);DMA_V(1,SLOTB);
  ROT();
  kload8(kf,kp0+sl_cur);
  WAIT_BAR(2);
  s16x4 vlo[8],vhi[8]; u32x4 pw0,pw1,pw2,pw3;
  #define PKW(P,B) cvtpk_s(P[B],P[B+1])
  #define PAF(k) __builtin_bit_cast(bf16x8,pw##k)
  #define VFR(i) (bf16x8){vlo[i][0],vlo[i][1],vlo[i][2],vlo[i][3],vhi[i][0],vhi[i][1],vhi[i][2],vhi[i][3]}
  #define PIN(x) asm volatile("":"+v"(x))
  #define MX3(a,b,c) __builtin_fmaxf(__builtin_fmaxf((a),(b)),(c))
  #define GAPA(MF,A0,A1,A2,A3,W0,W1,PW) do{ MF; sacc+=A0; sacc+=A1; sacc+=A2; sacc+=A3; PIN(sacc); W0; W1; PIN(PW); SBAR(); }while(0)
  #define EX(v) __builtin_amdgcn_exp2f(v)
  #define GAPB(MF,X,B) do{ MF; X[B]=EX(X[B]); X[B+1]=EX(X[B+1]); X[B+2]=EX(X[B+2]); X[B+3]=EX(X[B+3]); PIN(X); SBAR(); }while(0)
  #define VRD(i) do{ vlo[i]=vtr(vp_+(((i)>>2)*4096+((i)&3)*1024)); vhi[i]=vtr(vp_+(((i)>>2)*4096+((i)&3)*1024+512)); }while(0)
  #define KRD(G,j) do{ if(G){ kload2(kf,kp0+sl_next,j); SBAR(); } }while(0)
  #define STEP(C0,C1,P0,P1,t,GK,GV,GL) do{ SBAR(); \
    const lds_cptr vp_=vp0+sl_prev; \
    VRD(0); SBAR(); float sacc=(P0[0]+P0[1]); \
    GAPA(C0=__builtin_amdgcn_mfma_f32_32x32x16_bf16(kf[0],qr[0],negm,0,0,0), P0[2],P0[3],P0[4],P0[5],     pw0[0]=PKW(P0,0), pw0[1]=PKW(P0,2), pw0); \
    VRD(4); SBAR(); GAPA(C1=__builtin_amdgcn_mfma_f32_32x32x16_bf16(kf[1],qr[0],negm,0,0,0), P0[6],P0[7],P0[8],P0[9],     pw0[2]=PKW(P0,4), pw0[3]=PKW(P0,6), pw0); \
    VRD(1); SBAR(); GAPA(C0=__builtin_amdgcn_mfma_f32_32x32x16_bf16(kf[2],qr[1],C0,0,0,0),   P0[10],P0[11],P0[12],P0[13], pw1[0]=PKW(P0,8), pw1[1]=PKW(P0,10), pw1); \
    VRD(5); SBAR(); GAPA(C1=__builtin_amdgcn_mfma_f32_32x32x16_bf16(kf[3],qr[1],C1,0,0,0),   P0[14],P0[15],P1[0],P1[1],   pw1[2]=PKW(P0,12),pw1[3]=PKW(P0,14), pw1); \
    VRD(2); SBAR(); GAPA(C0=__builtin_amdgcn_mfma_f32_32x32x16_bf16(kf[4],qr[2],C0,0,0,0),   P1[2],P1[3],P1[4],P1[5],     pw2[0]=PKW(P1,0), pw2[1]=PKW(P1,2), pw2); \
    VRD(6); SBAR(); GAPA(C1=__builtin_amdgcn_mfma_f32_32x32x16_bf16(kf[5],qr[2],C1,0,0,0),   P1[6],P1[7],P1[8],P1[9],     pw2[2]=PKW(P1,4), pw2[3]=PKW(P1,6), pw2); \
    VRD(3); SBAR(); GAPA(C0=__builtin_amdgcn_mfma_f32_32x32x16_bf16(kf[6],qr[3],C0,0,0,0),   P1[10],P1[11],P1[12],P1[13], pw3[0]=PKW(P1,8), pw3[1]=PKW(P1,10), pw3); \
    VRD(7); SBAR(); GAPA(C1=__builtin_amdgcn_mfma_f32_32x32x16_bf16(kf[7],qr[3],C1,0,0,0),   P1[14],P1[15],0.f,0.f,       pw3[2]=PKW(P1,12),pw3[3]=PKW(P1,14), pw3); \
    l_reg+=sacc; \
    if(GK){DMA_K((t)+3,sl_cur);} if(GV){DMA_V((t)+1,sl_next);} \
    CMASK(C0,C1,t); \
    { float a=MX3(C0[0],C0[1],C1[0]),b=MX3(C0[2],C0[3],C1[1]); a=MX3(a,C1[2],C1[3]); \
      _Pragma("unroll") for(int r=4;r<16;r+=4){a=MX3(a,C0[r],C0[r+1]);b=MX3(b,C0[r+2],C0[r+3]);a=MX3(a,C1[r],C1[r+1]);b=MX3(b,C1[r+2],C1[r+3]);} \
      float rm=__builtin_fmaxf(a,b); { auto rr=__builtin_amdgcn_permlane32_swap(__float_as_uint(rm),__float_as_uint(rm),false,false); rm=__builtin_fmaxf(__uint_as_float(rr[0]),__uint_as_float(rr[1])); } \
      resc=false; \
      if(__builtin_expect(__any(rm>(float)THRL),0)){ const float dl=__builtin_fmaxf(rm,0.f); mhat+=dl; \
        _Pragma("unroll") for(int r=0;r<16;++r){C0[r]-=dl;C1[r]-=dl;} \
        _Pragma("unroll") for(int r=0;r<16;++r)negm[r]=-mhat; asm volatile("":"+v"(negm)); \
        const float f=__builtin_amdgcn_exp2f(-dl); l_reg*=f; if(hi==0)wsf[r32]=f; resc=true; } } \
    SBAR(); \
    GAPB(o[0]=__builtin_amdgcn_mfma_f32_32x32x16_bf16(PAF(0),VFR(0),o[0],0,0,0), C0,0); \
    GAPB(o[1]=__builtin_amdgcn_mfma_f32_32x32x16_bf16(PAF(0),VFR(4),o[1],0,0,0), C0,4); \
    KRD(GL,0); GAPB(o[0]=__builtin_amdgcn_mfma_f32_32x32x16_bf16(PAF(1),VFR(1),o[0],0,0,0), C0,8); \
    KRD(GL,1); GAPB(o[1]=__builtin_amdgcn_mfma_f32_32x32x16_bf16(PAF(1),VFR(5),o[1],0,0,0), C0,12); \
    KRD(GL,2); GAPB(o[0]=__builtin_amdgcn_mfma_f32_32x32x16_bf16(PAF(2),VFR(2),o[0],0,0,0), C1,0); \
    KRD(GL,3); GAPB(o[1]=__builtin_amdgcn_mfma_f32_32x32x16_bf16(PAF(2),VFR(6),o[1],0,0,0), C1,4); \
    GAPB(o[0]=__builtin_amdgcn_mfma_f32_32x32x16_bf16(PAF(3),VFR(3),o[0],0,0,0), C1,8); \
    GAPB(o[1]=__builtin_amdgcn_mfma_f32_32x32x16_bf16(PAF(3),VFR(7),o[1],0,0,0), C1,12); \
    }while(0)
  int t=1;
  #undef CMASK
  #define CMASK(P0,P1,t) do{}while(0)
#ifdef ATT_LOOP_ALIGN
  asm volatile(ATT_LOOP_ALIGN:::"memory");
#endif
  for(;t+5<NT;t+=2){
    STEP(pB0,pB1,pA0,pA1,t,true,true,true);     WAIT_BAR(2); RESC(); ROT();
    STEP(pA0,pA1,pB0,pB1,t+1,true,true,true);   WAIT_BAR(2); RESC(); ROT();
  }
  #undef CMASK
  #define CMASK(P0,P1,t) do{}while(0)
  #define ENDW(tt) do{ if((tt)+3<NT){WAIT_BAR(2);} else if((tt)+2<NT){WAIT_BAR(1);} else {WAIT_BAR(0);} }while(0)
  for(;t+1<NT;t+=2){
    STEP(pB0,pB1,pA0,pA1,t,(t+3<NT),(t+1<NT),(t+1<NT));       ENDW(t);   RESC(); ROT();
    STEP(pA0,pA1,pB0,pB1,t+1,(t+4<NT),(t+2<NT),(t+2<NT));     ENDW(t+1); RESC(); ROT();
  }
  STEP(pB0,pB1,pA0,pA1,NT-1,false,false,false); RESC();
  { float sacc=pB0[0]+pB0[1]; _Pragma("unroll") for(int r=2;r<16;++r)sacc+=pB0[r]; _Pragma("unroll") for(int r=0;r<16;++r)sacc+=pB1[r]; l_reg+=sacc;
    pw0=(u32x4){PKW(pB0,0),PKW(pB0,2),PKW(pB0,4),PKW(pB0,6)};pw1=(u32x4){PKW(pB0,8),PKW(pB0,10),PKW(pB0,12),PKW(pB0,14)};pw2=(u32x4){PKW(pB1,0),PKW(pB1,2),PKW(pB1,4),PKW(pB1,6)};pw3=(u32x4){PKW(pB1,8),PKW(pB1,10),PKW(pB1,12),PKW(pB1,14)};
    SBAR(); pv(o,vb0+sl_cur,PAF(0),PAF(1),PAF(2),PAF(3)); }
  #undef PKW
  #undef PAF
  #undef VFR
  #undef PIN
  #undef MX3
  #undef GAPA
  #undef GAPB
  #undef EX
  #undef VRD
  #undef KRD
  #undef STEP
  #undef ENDW
  {auto rr=__builtin_amdgcn_permlane32_swap(__float_as_uint(l_reg),__float_as_uint(l_reg),false,false);l_reg=__uint_as_float(rr[0])+__uint_as_float(rr[1]);}
  if(hi==0)wsf[32+r32]=l_reg;asm volatile("s_waitcnt lgkmcnt(0)":::"memory");
  float rli[16];
  #pragma unroll
  for(int r=0;r<16;++r)rli[r]=__builtin_amdgcn_rcpf(wsf[32+crow(r,hi)]);
  bf16*Ow=O+(rowbase+q0+wid*QBLK)*OPITCH+512+h*D;
  { bf16*stg=(bf16*)(shm+LDS_OST)+wid*2048;
    #pragma unroll
    for(int r=0;r<16;++r){const int orow=crow(r,hi);
      #pragma unroll
      for(int d0=0;d0<2;++d0)stg[orow*64+d0*32+r32]=__float2bfloat16(o[d0][r]*rli[r]);}
    asm volatile("s_waitcnt lgkmcnt(0)":::"memory");
    #pragma unroll
    for(int i=0;i<4;++i){const int row=i*8+(lane>>3),ch=lane&7; const u32x4 v=*(const u32x4*)(stg+row*64+ch*8); const u32x4 gt=*(const u32x4*)(shm+LDS_GATE+wid*4096+i*1024+lane*16); u32x4 w;
      _Pragma("unroll") for(int e=0;e<4;++e){ const float a0=__uint_as_float(v[e]<<16)*__uint_as_float(gt[e]<<16), a1=__uint_as_float(v[e]&0xffff0000u)*__uint_as_float(gt[e]&0xffff0000u); w[e]=cvtpk_s(a0,a1); }
#if TILED_OPERANDS
      ATTN_STORE16((char*)O+pg8::tiled_off((int)(rowbase+q0+wid*QBLK)+row,512+h*D+ch*8,OPITCH),w);} }
#else
      ATTN_STORE16(Ow+(long)row*OPITCH+ch*8,w);} }
#endif
  asm volatile("s_waitcnt lgkmcnt(0)\n\ts_barrier":::"memory");
  #undef DMA_K
  #undef DMA_V
  #undef CMASK
  #undef START
  #undef RESC
  #undef ROT
}
constexpr int ATTN_LDS_BYTES=LDS_BYTES;
#undef SBAR
#undef WAIT_BAR
}
namespace ret_body {
using attn_body::bf16x8; using attn_body::s16x4; using attn_body::f32x16; using attn_body::u32x4; using attn_body::glds16; using attn_body::vtr; using attn_body::cvtpk_s; using attn_body::crow; using attn_body::lds_cptr;
typedef unsigned u32x2 __attribute__((ext_vector_type(2)));
typedef float f32x4 __attribute__((ext_vector_type(4)));
constexpr int PP = 128; constexpr long HSZ = (long)81920 * 128; constexpr int QOFF = 0, KOFF = 4, VOFF = 8, GOFF = 12;
constexpr float LOG2E = 1.4426950408889634f;
#define RB_WAITV0_BAR() asm volatile("s_waitcnt vmcnt(0) lgkmcnt(0)\n\ts_barrier" ::: "memory")
#define RB_BAR() asm volatile("s_waitcnt lgkmcnt(0)\n\ts_barrier" ::: "memory")
__device__ __forceinline__ size_t rt_off(int dir, int cgl, int h) { return ((size_t)(dir * 640 + cgl) * 4 + h) * 32768; }
__device__ __forceinline__ s16x4 scale4(s16x4 v, float w0, float w1, float w2, float w3) {
    const u32x2 u = __builtin_bit_cast(u32x2, v); u32x2 o;
    o[0] = cvtpk_s(__uint_as_float(u[0] << 16) * w0, __uint_as_float(u[0] & 0xffff0000u) * w1);
    o[1] = cvtpk_s(__uint_as_float(u[1] << 16) * w2, __uint_as_float(u[1] & 0xffff0000u) * w3);
    return __builtin_bit_cast(s16x4, o);
}
__device__ __forceinline__ bf16x8 scale8(bf16x8 v, float w) {
    const u32x4 u = __builtin_bit_cast(u32x4, v); u32x4 o;
#pragma unroll
    for (int e = 0; e < 4; ++e) o[e] = cvtpk_s(__uint_as_float(u[e] << 16) * w, __uint_as_float(u[e] & 0xffff0000u) * w);
    return __builtin_bit_cast(bf16x8, o);
}
__device__ __forceinline__ void dma_timg(const bf16* P, long row0, int slot, unsigned dst, int wid, int lane) { P += slot * HSZ;
#pragma unroll
    for (int i = 0; i < 4; ++i) { const int p = wid * 4 + i, db = p >> 3, kg = p & 7;
        glds16(P + (row0 + 16 * kg + (lane >> 2)) * PP + db * 32 + (lane & 3) * 8, (unsigned)__builtin_amdgcn_readfirstlane(dst + p * 1024)); }
}
__device__ __forceinline__ void dma_kimg(const bf16* P, long row0, int slot, unsigned dst, int wid, int lane) { P += slot * HSZ;
#pragma unroll
    for (int i = 0; i < 4; ++i) { const int p = wid * 4 + i, c16 = p >> 1, th = p & 1;
        glds16(P + (row0 + 64 * th + lane) * PP + c16 * 8, (unsigned)__builtin_amdgcn_readfirstlane(dst + p * 1024)); }
}
__device__ __forceinline__ void dma_lin(const unsigned char* src, unsigned dst, int wid, int lane) {
#pragma unroll
    for (int i = 0; i < 4; ++i) { const int p = wid * 4 + i; glds16(src + p * 1024 + lane * 16, (unsigned)__builtin_amdgcn_readfirstlane(dst + p * 1024)); }
}


#define RB_WAITV(n) asm volatile("s_waitcnt vmcnt(" #n ") lgkmcnt(0)\n\ts_barrier" ::: "memory")
#define RB_TOPX(rem) do { RB_TOP(rem); if (EXP == 4) { __builtin_amdgcn_s_sleep(32); } } while (0)
#define RB_TOP(rem) do { if ((rem) >= 2) RB_WAITV(8); else if ((rem) == 1) RB_WAITV(4); else RB_WAITV(0); } while (0)

__device__ __forceinline__ void dma_timg8(const bf16* P, long row0, int slot, unsigned dst, int lw, int lane) { P += slot * HSZ;
#pragma unroll
    for (int i = 0; i < 8; ++i) { const int p = lw * 8 + i, db = p >> 3, kg = p & 7;
        glds16(P + (row0 + 16 * kg + (lane >> 2)) * PP + db * 32 + (lane & 3) * 8, (unsigned)__builtin_amdgcn_readfirstlane(dst + p * 1024)); }
}
__device__ __forceinline__ void dma_kimg8(const bf16* P, long row0, int slot, unsigned dst, int lw, int lane) { P += slot * HSZ;
#pragma unroll
    for (int i = 0; i < 8; ++i) { const int p = lw * 8 + i, c16 = p >> 1, th = p & 1;
        glds16(P + (row0 + 64 * th + lane) * PP + c16 * 8, (unsigned)__builtin_amdgcn_readfirstlane(dst + p * 1024)); }
}
__device__ __forceinline__ void dma_lin8(const unsigned char* src, unsigned dst, int lw, int lane) {
#pragma unroll
    for (int i = 0; i < 8; ++i) { const int p = lw * 8 + i; glds16(src + p * 1024 + lane * 16, (unsigned)__builtin_amdgcn_readfirstlane(dst + p * 1024)); }
}
#define RB_WAITL(n) asm volatile("s_waitcnt vmcnt(" #n ") lgkmcnt(0)\n\ts_barrier" ::: "memory")
#define RB_TOPL(rem) do { if ((rem) >= 2) RB_WAITL(16); else if ((rem) == 1) RB_WAITL(8); else RB_WAITL(0); } while (0)
#define RB_TOPC() asm volatile("s_waitcnt lgkmcnt(0)\n\ts_barrier" ::: "memory")

__device__ __forceinline__ void scan_dma(const bf16* P, int cgl, int half, int h, unsigned slot, int lw, int lane) {
#pragma unroll
    for (int i = 0; i < 8; ++i) { const int p = lw * 8 + i, mat = p >> 4, q = p & 15;
        const unsigned char* src = (const unsigned char*)(P + ((mat ? VOFF : KOFF) + h) * HSZ + (long)cgl * 16384) + (mat ? (q >> 2) * 8192 + (4 * half + (q & 3)) * 1024 : q * 2048 + half * 1024) + lane * 16;
        glds16(src, (unsigned)__builtin_amdgcn_readfirstlane(slot + mat * 16384 + q * 1024)); }
}
__device__ __forceinline__ void scan_item(int b, int h, int dir, const bf16* P, unsigned char* RT, const float* lrf, const float* lrb, char* shm) {
    int tid = threadIdx.x; asm volatile("" : "+v"(tid));
    const int lane = tid & 63, r32 = lane & 31, hi = lane >> 5; const int wid = __builtin_amdgcn_readfirstlane(tid >> 6);
    const long rowbase = b < 4 ? (long)b * 4096 : (long)NTOK_P + (long)(b - 4) * 2048; const int N = b < 4 ? 32 : 16, J = 2 * N;
    const unsigned lds0 = (unsigned)(uintptr_t)shm; const lds_cptr shm3 = (lds_cptr)shm;
    const int n0 = dir ? N - 1 : 0, dn = dir ? -1 : 1;
#define SC_CG(j) ((int)(rowbase >> 7) + n0 + ((j) >> 1) * dn)
    if (wid >= 4) {
        const int lw = wid - 4;
        scan_dma(P, SC_CG(0), 0, h, lds0, lw, lane); scan_dma(P, SC_CG(1), 1, h, lds0 + 32768, lw, lane); scan_dma(P, SC_CG(2), 0, h, lds0 + 65536, lw, lane);
        for (int j = 0; j < J; ++j) {
            RB_TOPL(J - 1 - j);
            if (j + 3 < J) scan_dma(P, SC_CG(j + 3), (j + 3) & 1, h, lds0 + ((j + 3) & 3) * 32768, lw, lane);
        }
        RB_TOPC();
    } else {
        const float lg = -__expf(dir ? lrb[h] : lrf[h]) * LOG2E;
        const float gC = __builtin_amdgcn_exp2f(lg * 128.f);
        const int db = wid;
        const int troff = ((lane >> 4) & 1) * 32 + (lane & 3) * 8 + (4 * hi + ((lane & 15) >> 2)) * 64;
        f32x16 st[4]; st[0] = f32x16{}; st[1] = f32x16{}; st[2] = f32x16{}; st[3] = f32x16{};
        float wj[8];
#pragma unroll
        for (int j = 0; j < 8; ++j) { const int oj = 8 * (j >> 2) + 4 * hi + (j & 3); wj[j] = __builtin_amdgcn_exp2f(lg * (float)(dir ? oj : 15 - oj)); }
        for (int j = 0; j < J; ++j) {
            const int half = j & 1, slot = (j & 3) * 32768;
            RB_TOPC();
            if (half == 0) {
                unsigned char* img = RT + rt_off(dir, (int)((rowbase >> 7) + n0 + (j >> 1) * dn), h);
#pragma unroll
                for (int et = 0; et < 4; ++et) { const int e = 32 * et + r32;
#pragma unroll
                    for (int rp = 0; rp < 2; ++rp) {
                        u32x2 w[2];
#pragma unroll
                        for (int k = 0; k < 2; ++k) { const int r4 = 2 * rp + k; w[k][0] = cvtpk_s(st[et][4 * r4], st[et][4 * r4 + 1]); w[k][1] = cvtpk_s(st[et][4 * r4 + 2], st[et][4 * r4 + 3]); }
                        const auto s0 = __builtin_amdgcn_permlane32_swap(w[0][0], w[1][0], false, false), s1 = __builtin_amdgcn_permlane32_swap(w[0][1], w[1][1], false, false);
                        *(u32x4*)(img + (4 * db + 2 * rp + hi) * 2048 + e * 16) = (u32x4){s0[0], s1[0], s0[1], s1[1]}; }
#pragma unroll
                    for (int r = 0; r < 16; ++r) st[et][r] *= gC; } }
            const lds_cptr kb = shm3 + slot + (4 * db + 2 * ((lane >> 4) & 1) + ((lane & 3) >> 1)) * 1024 + (4 * hi + ((lane & 15) >> 2)) * 16 + (lane & 1) * 8, vb = shm3 + slot + 16384 + troff;
#pragma unroll
            for (int ks = 0; ks < 4; ++ks) {
                s16x4 klo = vtr(kb + ks * 256), khi = vtr(kb + ks * 256 + 128);
                const float bk = __builtin_amdgcn_exp2f(lg * (float)(dir ? 64 * half + 16 * ks : 112 - 64 * half - 16 * ks));
                float w[8];
#pragma unroll
                for (int jj = 0; jj < 8; ++jj) w[jj] = wj[jj] * bk;
                klo = scale4(klo, w[0], w[1], w[2], w[3]); khi = scale4(khi, w[4], w[5], w[6], w[7]);
                const bf16x8 af = (bf16x8){klo[0], klo[1], klo[2], klo[3], khi[0], khi[1], khi[2], khi[3]};
#pragma unroll
                for (int et = 0; et < 4; ++et) { const s16x4 vlo = vtr(vb + et * 4096 + ks * 1024), vhi = vtr(vb + et * 4096 + ks * 1024 + 512);
                    const bf16x8 bfr = (bf16x8){vlo[0], vlo[1], vlo[2], vlo[3], vhi[0], vhi[1], vhi[2], vhi[3]};
                    st[et] = __builtin_amdgcn_mfma_f32_32x32x16_bf16(af, bfr, st[et], 0, 0, 0); }
            }
        }
        RB_TOPC();
    }
#undef SC_CG
}

template <class Sched, int EXP = 0> __device__ __forceinline__ void retout_phase(const Sched& S, int nit, const bf16* P, const unsigned char* RT, bf16* O, const float* lrf, const float* lrb, const float* gng, char* shm) {
    int tid = threadIdx.x; asm volatile("" : "+v"(tid));
    const int lane = tid & 63, r32 = lane & 31, hi = lane >> 5; const int wid = __builtin_amdgcn_readfirstlane(tid >> 6);
    const unsigned lds0 = (unsigned)(uintptr_t)shm; const lds_cptr shm3 = (lds_cptr)shm;
    const int G = 6 * nit;
    float* gn_l = (float*)(shm + 131072); float* lg_l = gn_l + 512;
    gn_l[tid] = gng[tid]; if (tid < 8) lg_l[tid] = -__expf(tid < 4 ? lrf[tid] : lrb[tid - 4]) * LOG2E;
    asm volatile("s_waitcnt vmcnt(0) lgkmcnt(0)" ::: "memory");
    if (nit <= 0) return;
    if (wid >= 4) {
        const int lw = wid - 4;
#define RO_ISSUE(g_) do { const int gq_ = (g_); if (EXP != 3 && gq_ < G) { const int it_ = gq_ / 6, st_ = gq_ - 6 * it_; int cg_, h_; S.item(it_, cg_, h_); const long r0_ = (long)cg_ * 128; const unsigned dst_ = lds0 + ((gq_ & 3) << 15); \
        if (st_ == 0) dma_lin8((const unsigned char*)(P + (QOFF + h_) * HSZ + (long)cg_ * 16384), dst_, lw, lane); else if (st_ == 1) dma_lin8((const unsigned char*)(P + (KOFF + h_) * HSZ + (long)cg_ * 16384), dst_, lw, lane); \
        else if (st_ == 2) dma_lin8((const unsigned char*)(P + (VOFF + h_) * HSZ + (long)cg_ * 16384), dst_, lw, lane); else if (st_ == 3) dma_lin8(RT + rt_off(0, cg_, h_), dst_, lw, lane); \
        else if (st_ == 4) dma_lin8(RT + rt_off(1, cg_, h_), dst_, lw, lane); else dma_lin8((const unsigned char*)(P + (GOFF + h_) * HSZ + (long)cg_ * 16384), dst_, lw, lane); } } while (0)
        RO_ISSUE(0); RO_ISSUE(1); RO_ISSUE(2);
        for (int g = 0; g < G; ++g) { RB_TOPL(G - 1 - g); RO_ISSUE(g + 3); }
        RB_TOPC();
#undef RO_ISSUE
        return;
    }
    const int cw = wid, c = 32 * cw + r32;
    const int troff = ((lane >> 4) & 1) * 32 + (lane & 3) * 8 + (4 * hi + ((lane & 15) >> 2)) * 64;
    for (int i = 0; i < nit; ++i) {
        int cgl, h; S.item(i, cgl, h);
        const long row0 = (long)cgl * 128; const int g0 = 6 * i;
        bf16x8 qr[8]; u32x4 pw[8]; f32x16 o[4]; o[0] = f32x16{}; o[1] = f32x16{}; o[2] = f32x16{}; o[3] = f32x16{};
        RB_TOPC();
        { const lds_cptr qp = shm3 + ((g0 & 3) << 15) + hi * 2048 + c * 16;
#pragma unroll
          for (int s = 0; s < 8; ++s) qr[s] = *(const __attribute__((address_space(3))) bf16x8*)(qp + s * 4096); }
        const float lgf = lg_l[h], lgb = lg_l[4 + h], nlgb = -lgb; float cfb = (float)(c - 4 * hi); asm volatile("" : "+v"(cfb));
        RB_TOPC();
        { const lds_cptr kp = shm3 + (((g0 + 1) & 3) << 15) + hi * 2048 + r32 * 16;
#pragma unroll
          for (int kb = 0; kb < 4; ++kb) {
              f32x16 p = f32x16{};
#pragma unroll
              for (int s = 0; s < 8; ++s) { const bf16x8 kf = *(const __attribute__((address_space(3))) bf16x8*)(kp + s * 4096 + kb * 512); p = __builtin_amdgcn_mfma_f32_32x32x16_bf16(kf, qr[s], p, 0, 0, 0); }
#pragma unroll
              for (int r = 0; r < 16; ++r) { const float x = cfb - (float)(32 * kb + (r & 3) + 8 * (r >> 2)); p[r] *= __builtin_amdgcn_exp2f((x >= 0.f ? lgf : nlgb) * x); }
#pragma unroll
              for (int e = 0; e < 4; ++e) { pw[2 * kb][e] = cvtpk_s(p[2 * e], p[2 * e + 1]); pw[2 * kb + 1][e] = cvtpk_s(p[8 + 2 * e], p[8 + 2 * e + 1]); }
              __builtin_amdgcn_sched_barrier(0);
          } }
        RB_TOPC();
        { const lds_cptr vb = shm3 + (((g0 + 2) & 3) << 15) + troff;
#pragma unroll
          for (int ks = 0; ks < 8; ++ks)
#pragma unroll
              for (int d0 = 0; d0 < 4; ++d0) { const s16x4 vlo = vtr(vb + d0 * 8192 + ks * 1024), vhi = vtr(vb + d0 * 8192 + ks * 1024 + 512);
                  o[d0] = __builtin_amdgcn_mfma_f32_32x32x16_bf16((bf16x8){vlo[0], vlo[1], vlo[2], vlo[3], vhi[0], vhi[1], vhi[2], vhi[3]}, __builtin_bit_cast(bf16x8, pw[ks]), o[d0], 0, 0, 0); if (d0 == 3 && (ks & 1)) __builtin_amdgcn_sched_barrier(0); } }
#pragma unroll
        for (int dir = 0; dir < 2; ++dir) {
            RB_TOPC();
            const float dec = __builtin_amdgcn_exp2f(dir ? lgb * (float)(128 - c) : lgf * (float)(c + 1));
            const lds_cptr rp = shm3 + (((g0 + 3 + dir) & 3) << 15) + hi * 2048 + r32 * 16;
#pragma unroll
            for (int s = 0; s < 8; ++s) { const bf16x8 qs = scale8(qr[s], dec);
#pragma unroll
                for (int d0 = 0; d0 < 4; ++d0) { const bf16x8 rf = *(const __attribute__((address_space(3))) bf16x8*)(rp + s * 4096 + d0 * 512); o[d0] = __builtin_amdgcn_mfma_f32_32x32x16_bf16(rf, qs, o[d0], 0, 0, 0); }
                if (s & 1) __builtin_amdgcn_sched_barrier(0); }
        }
        float rs;
        { float ss = 0.f;
#pragma unroll
          for (int d0 = 0; d0 < 4; ++d0)
#pragma unroll
              for (int r = 0; r < 16; ++r) ss += o[d0][r] * o[d0][r];
          const auto rr = __builtin_amdgcn_permlane32_swap(__float_as_uint(ss), __float_as_uint(ss), false, false); ss = __uint_as_float(rr[0]) + __uint_as_float(rr[1]);
          rs = rsqrtf(ss * (1.f / 128.f) + EPS); }
        RB_TOPC();
        { const lds_cptr gp = shm3 + (((g0 + 5) & 3) << 15) + c * 16 + 8 * hi;
          bf16* Ow = O + (row0 + c) * 1024 + h * 128;
#pragma unroll
          for (int d0 = 0; d0 < 4; ++d0)
#pragma unroll
              for (int rp = 0; rp < 2; ++rp) {
                  u32x2 w[2];
#pragma unroll
                  for (int k = 0; k < 2; ++k) { const int r4 = 2 * rp + k, e0 = 32 * d0 + 8 * r4 + 4 * hi;
                      const u32x2 gt = *(const __attribute__((address_space(3))) u32x2*)(gp + (4 * d0 + r4) * 2048); const f32x4 gn = *(const f32x4*)(gn_l + h * 128 + e0);
                      w[k][0] = cvtpk_s(o[d0][4 * r4] * rs * gn[0] * __uint_as_float(gt[0] << 16), o[d0][4 * r4 + 1] * rs * gn[1] * __uint_as_float(gt[0] & 0xffff0000u));
                      w[k][1] = cvtpk_s(o[d0][4 * r4 + 2] * rs * gn[2] * __uint_as_float(gt[1] << 16), o[d0][4 * r4 + 3] * rs * gn[3] * __uint_as_float(gt[1] & 0xffff0000u)); }
                  const auto s0 = __builtin_amdgcn_permlane32_swap(w[0][0], w[1][0], false, false), s1 = __builtin_amdgcn_permlane32_swap(w[0][1], w[1][1], false, false);
                  const u32x4 ww = {s0[0], s1[0], s0[1], s1[1]};
#if TILED_OPERANDS
                  bf16* dst = (bf16*)((unsigned char*)O + pg8::tiled_off((int)row0 + c, h * 128 + 32 * d0 + 8 * (2 * rp + hi), 1024));
#else
                  bf16* dst = Ow + 32 * d0 + 8 * (2 * rp + hi);
#endif
#if WT_STORES
                  attn_body::store16_sc1(dst, ww);
#else
                  *(u32x4*)dst = ww;
#endif
              } }
    }
    RB_TOPC();
}
}
#define RLX_AGENT __ATOMIC_RELAXED, __HIP_MEMORY_SCOPE_AGENT
#define XB_TMO      128
#define XB_XCNT(j)  (256  + 64 * (j))
#define XB_XSUB(j)  (1280 + 64 * (j))
#define XB_XGEN(j)  (2304 + 64 * (j))
#define XB_TOP      3328
#define XB_TOPGEN   3392
#define XCD_BAR_WORDS 3456
#define XB_SPIN_CAP (1u << 18)

__device__ __forceinline__ unsigned xb_ld(unsigned* p)              { return __hip_atomic_load(p, __ATOMIC_RELAXED, __HIP_MEMORY_SCOPE_AGENT); }
__device__ __forceinline__ unsigned xb_add(unsigned* p, unsigned v) { return __hip_atomic_fetch_add(p, v, __ATOMIC_RELAXED, __HIP_MEMORY_SCOPE_AGENT); }
__device__ __forceinline__ unsigned xb_xcc_id() { return (unsigned)__builtin_amdgcn_s_getreg((3 << 11) | 20) & 0xFu; }
#define XB_SPIN(cond, bar) do { unsigned _sp = 0; while (cond) { __builtin_amdgcn_s_sleep(1); \
    if ((++_sp & 255u) == 0u) { if (xb_ld(&(bar)[XB_TMO])) break; if (_sp > XB_SPIN_CAP) { atomicAdd(&(bar)[XB_TMO], 1u); break; } } } } while (0)

struct XcdBarrier {
    unsigned* bar; unsigned x;
    volatile LAS unsigned* st;
};

__device__ __forceinline__ XcdBarrier xcd_barrier_post(unsigned* bar, volatile LAS unsigned* st) {
    XcdBarrier b; b.bar = bar; b.x = xb_xcc_id(); b.st = st;
    if (threadIdx.x == 0) (void)xb_add(&bar[XB_XCNT(b.x)], 1u);
    return b;
}
__device__ __forceinline__ void xcd_barrier_complete(unsigned* bar, unsigned x, unsigned& nloc, unsigned& nx) {
    const unsigned G = gridDim.x * gridDim.y * gridDim.z;
    unsigned sum, cnt, mine, sp = 0u;
    for (;;) {
        sum = 0u; cnt = 0u; mine = 0u;
#pragma unroll
        for (unsigned j = 0; j < 16; ++j) { const unsigned c = xb_ld(&bar[XB_XCNT(j)]); sum += c; cnt += (c > 0u) ? 1u : 0u; mine = (j == x) ? c : mine; }
        if (sum == G) break;
        __builtin_amdgcn_s_sleep(1);
        if ((++sp & 255u) == 0u) { if (xb_ld(&bar[XB_TMO])) break; if (sp > XB_SPIN_CAP) { atomicAdd(&bar[XB_TMO], 1u); break; } }
    }
    nloc = mine > 0u ? mine : 1u; nx = cnt > 0u ? cnt : 1u;
}

__device__ __forceinline__ void xcd_barrier(const XcdBarrier& b) {
    asm volatile("s_waitcnt vmcnt(0)" ::: "memory");
    __syncthreads();
    if (threadIdx.x == 0) {
        unsigned* bar = b.bar;
        __builtin_amdgcn_s_waitcnt(0);
        unsigned nloc = b.st[0], nx = b.st[1];
        if (nloc == 0u) { xcd_barrier_complete(bar, b.x, nloc, nx); b.st[0] = nloc; b.st[1] = nx; }
        const unsigned old = xb_add(&bar[XB_XSUB(b.x)], 1u);
        const unsigned gen = old / nloc;
        if (old + 1u == (gen + 1u) * nloc) {
            __builtin_amdgcn_fence(__ATOMIC_RELEASE, "agent");
            asm volatile("s_waitcnt vmcnt(0)" ::: "memory");
            const unsigned og = xb_add(&bar[XB_TOP], 1u);
            const unsigned tg = og / nx;
            if (og + 1u == (tg + 1u) * nx) xb_add(&bar[XB_TOPGEN], 1u);
            else XB_SPIN(xb_ld(&bar[XB_TOPGEN]) == tg, bar);
            __builtin_amdgcn_fence(__ATOMIC_ACQUIRE, "agent");
            xb_add(&bar[XB_XGEN(b.x)], 1u);
            asm volatile("s_waitcnt vmcnt(0)" ::: "memory");
        } else {
            XB_SPIN(xb_ld(&bar[XB_XGEN(b.x)]) == gen, bar);
            __builtin_amdgcn_fence(__ATOMIC_ACQUIRE, "agent");
            asm volatile("s_waitcnt vmcnt(0)" ::: "memory");
        }
    }
    __syncthreads();
}
constexpr int NWAVES = 8, NTHREADS = 512;
constexpr int RING_BYTES = 131072, LDS_PERSIST = 147456, LDS_TABA = 147456 + 256, LDS_BYTES = 147456 + 256 + 8192;
#define LDS_WAIT() asm volatile("s_waitcnt lgkmcnt(0)" ::: "memory")

struct Args { const float* in[14]; float* out; unsigned char* ws; int ph_lo, ph_hi; };

__device__ __forceinline__ void p0_mod_item(const Args& a, LAS unsigned char* lds, int item) {
    typedef float f4 __attribute__((ext_vector_type(4)));
    const int tid = threadIdx.x, lane = tid & 63, wave = tid >> 6, col = tid & 15, kl = tid >> 4, n0 = item * 16;
    const float* cp = a.in[2]; const float* cs = a.in[3]; const float* W = a.in[5]; const float* bias = a.in[6]; float* mod = (float*)(a.ws + WS_MOD);
    LAS float* sl = (LAS float*)lds;
    LAS float* red = (LAS float*)(lds + 40960);
    float acc[NB];
#pragma unroll
    for (int b = 0; b < NB; ++b) acc[b] = 0.f;
    float wv[4][8];
#pragma unroll
    for (int kc = 0; kc < 4; ++kc)
#pragma unroll
        for (int i = 0; i < 8; ++i) wv[kc][i] = W[(size_t)(kc * 256 + kl + 32 * i) * 3072 + n0 + col];
#pragma unroll
    for (int kc = 0; kc < 4; ++kc) {
        float wc[8];
#pragma unroll
        for (int i = 0; i < 8; ++i) wc[i] = wv[kc][i];
        __syncthreads();
        { float cv[18];
#pragma unroll
          for (int q = 0; q < 18; ++q) { const int e = tid + q * NTHREADS, b = e >> 8, k = e & 255; const float* c = b < 4 ? cp + b * DM : cs + (b - 4) * DM; cv[q] = c[kc * 256 + k]; }
#pragma unroll
          for (int q = 0; q < 18; ++q) { const int e = tid + q * NTHREADS, b = e >> 8, k = e & 255; sl[(k & 31) * 292 + b * 8 + (k >> 5)] = silu(cv[q]); } }
        __syncthreads();
#pragma unroll
        for (int b = 0; b < NB; ++b) { const f4 s0 = *(const LAS f4*)(sl + kl * 292 + b * 8), s1 = *(const LAS f4*)(sl + kl * 292 + b * 8 + 4);
            acc[b] += (s0[0] * wc[0] + s0[1] * wc[1]) + (s0[2] * wc[2] + s0[3] * wc[3]) + (s1[0] * wc[4] + s1[1] * wc[5]) + (s1[2] * wc[6] + s1[3] * wc[7]); }
    }
#pragma unroll
    for (int b = 0; b < NB; ++b) { acc[b] += __shfl_xor(acc[b], 16); acc[b] += __shfl_xor(acc[b], 32); }
    __syncthreads();
    if (lane < 16) {
#pragma unroll
        for (int b = 0; b < NB; ++b) red[(wave * NB + b) * 16 + col] = acc[b]; }
    __syncthreads();
    for (int e = tid; e < NB * 16; e += NTHREADS) { const int b = e >> 4, c = e & 15; float s = 0.f;
        for (int w = 0; w < 8; ++w) s += red[(w * NB + b) * 16 + c];
        mod[b * 3072 + n0 + c] = s + bias[n0 + c]; }
    __syncthreads();
}
__device__ __forceinline__ void p0_transpose_item(const float* W, int K, int N, bf16* WT, bool perm, LAS float* scr, int item, int lane) {
    const int nblk = N / 32, kb = item / nblk, nb = item % nblk, k0 = 64 * kb, n0 = 32 * nb;
    float t_[32];
#pragma unroll
    for (int i = 0; i < 32; ++i) t_[i] = W[(size_t)(k0 + 2 * i + (lane >> 5)) * N + n0 + (lane & 31)];
#pragma unroll
    for (int i = 0; i < 32; ++i) scr[(2 * i + (lane >> 5)) * 33 + (lane & 31)] = t_[i];
    LDS_WAIT(); asm volatile("" ::: "memory");
    const int c = lane & 7;
#pragma unroll
    for (int j = 0; j < 4; ++j) { const int n = (lane >> 3) + 8 * j; const LAS float* s = scr + (8 * c) * 33 + n;
        uint4 o; o.x = pk2(s[0 * 33], s[1 * 33]); o.y = pk2(s[2 * 33], s[3 * 33]); o.z = pk2(s[4 * 33], s[5 * 33]); o.w = pk2(s[6 * 33], s[7 * 33]);
#if TILED_OPERANDS
        *(uint4*)((unsigned char*)WT + pg8::tiled_off(perm ? pg8::in_physrow(n0 + n) : n0 + n, k0 + 8 * c, K)) = o; }
#else
        *(uint4*)(WT + (size_t)(perm ? pg8::in_physrow(n0 + n) : n0 + n) * K + k0 + 8 * c) = o; }
#endif
    LDS_WAIT(); asm volatile("" ::: "memory");
}
__device__ __forceinline__ void p0_prologue(const Args& a, LAS unsigned char* lds) {
    const int tid = threadIdx.x, lane = tid & 63, wave = __builtin_amdgcn_readfirstlane(tid >> 6), G = gridDim.x;
    for (int it = blockIdx.x; it < 192; it += G) p0_mod_item(a, lds, it);
#ifdef DBL_MOD
    for (int it = blockIdx.x; it < 192; it += G) p0_mod_item(a, lds, it);
#endif
    __syncthreads();
    if ((int)blockIdx.x == G - 1) {
        float* tabR = (float*)(a.ws + WS_TAB); float* tabA = tabR + 4096;
        for (int e = tid; e < 2048; e += NTHREADS) { const int pos = e >> 5, i = e & 31; float sn, cs; sincosf((float)pos * powf(10000.f, -(float)i / 32.f), &sn, &cs); tabR[e] = cs; tabR[2048 + e] = sn; }
        for (int e = tid; e < 1024; e += NTHREADS) { const int pos = e >> 4, i = e & 15; float sn, cs; sincosf((float)pos * powf(10000.f, -(float)i / 16.f), &sn, &cs); tabA[e] = cs; tabA[1024 + e] = sn; }
    }
    LAS float* scr = (LAS float*)(lds + wave * 16384);
    const int gw = (G - 1 - (int)blockIdx.x) * NWAVES + wave, NGW = G * NWAVES;
    constexpr int I_IN = (DM / 64) * (INC / 32), I_OUT = (DM / 64) * (DM / 32);
    for (int it = gw; it < I_IN + I_OUT; it += NGW) {
        if (it < I_IN) p0_transpose_item(a.in[7], DM, INC, (bf16*)(a.ws + WS_WIN), true, scr, it, lane);
        else p0_transpose_item(a.in[13], DM, DM, (bf16*)(a.ws + WS_WOUT), false, scr, it - I_IN, lane);
    }
}
__device__ __forceinline__ void p1_norm(const Args& a) {
    typedef float f4 __attribute__((ext_vector_type(4)));
    const int tid = threadIdx.x, lane = tid & 63, wave = tid >> 6; const int gw = blockIdx.x * NWAVES + wave, NGW = gridDim.x * NWAVES;
    const float* mod = (const float*)(a.ws + WS_MOD); bf16* H = (bf16*)(a.ws + WS_H);
    const int per = (M + NGW - 1) / NGW; int curb = -1; f4 gs[4], sh[4];
    for (int m = gw * per; m < M && m < (gw + 1) * per; ++m) {
        const int b = batch_of(m);
        if (b != curb) { curb = b;
#pragma unroll
            for (int j = 0; j < 4; ++j) { const f4 g = ((const f4*)a.in[4])[lane + 64 * j], sc = ((const f4*)(mod + b * 3072 + 1024))[lane + 64 * j]; gs[j] = g * (1.f + sc); sh[j] = ((const f4*)(mod + b * 3072))[lane + 64 * j]; } }
        const float* x = m < NTOK_P ? a.in[0] + (size_t)m * DM : a.in[1] + (size_t)(m - NTOK_P) * DM;
        f4 v[4]; float s = 0.f;
#pragma unroll
        for (int j = 0; j < 4; ++j) { v[j] = ((const f4*)x)[lane + 64 * j]; s += (v[j][0] * v[j][0] + v[j][1] * v[j][1]) + (v[j][2] * v[j][2] + v[j][3] * v[j][3]); }
#pragma unroll
        for (int o = 1; o < 64; o <<= 1) s += __shfl_xor(s, o);
        const float r = rsqrtf(s * (1.f / DM) + EPS);
        unsigned long long* o8 = (unsigned long long*)(H + (size_t)m * DM) + lane;
#pragma unroll
        for (int j = 0; j < 4; ++j) { const f4 y = v[j] * r * gs[j] + sh[j]; o8[64 * j] = (unsigned long long)pk2(y[0], y[1]) | ((unsigned long long)pk2(y[2], y[3]) << 32); }
    }
}
#ifndef MERGED_MIX
#define MERGED_MIX 1
#endif
#ifndef MX_ORDER
#define MX_ORDER 0
#endif
#ifndef FUSED_NORM
#define FUSED_NORM 1
#endif
#ifndef NOFENCE
#define NOFENCE 0
#endif

__device__ __forceinline__ void p3_scan(const Args& a, char* shm) {
    for (int it = blockIdx.x; it < 288; it += gridDim.x) {
        int b, h, dir;
        if (it < 32) { b = it >> 3; h = (it >> 1) & 3; dir = it & 1; } else { const int j = it - 32; b = 4 + (j >> 3); h = (j >> 1) & 3; dir = j & 1; }
        ret_body::scan_item(b, h, dir, (const bf16*)(a.ws + WS_PROJ), a.ws + WS_RT, a.in[8], a.in[9], shm);
    }
}
struct RetStatic { int base, G; __device__ __forceinline__ void item(int i, int& cgl, int& h) const { const int it = base + i * G; cgl = it >> 2; h = it & 3; } };
template <int EXP = 0> __device__ __forceinline__ void p4_retout(const Args& a, char* shm) {
    const RetStatic S{(int)blockIdx.x, (int)gridDim.x}; const int nit = (2560 - (int)blockIdx.x + (int)gridDim.x - 1) / (int)gridDim.x;
    ret_body::retout_phase<RetStatic, EXP>(S, nit, (const bf16*)(a.ws + WS_PROJ), a.ws + WS_RT, (bf16*)(a.ws + WS_MIX), a.in[8], a.in[9], a.in[10], shm);
}
template <int MAP = 0, int ROT = 0> __device__ __forceinline__ void p5_attn(const Args& a, char* shm) {
    const int G = gridDim.x; const attn_body::bf16* P = (const attn_body::bf16*)(a.ws + WS_PROJ); attn_body::bf16* O = (attn_body::bf16*)(a.ws + WS_MIX);
    if (G == 256) {
        const int x = MAP == 0 ? (blockIdx.x & 7) : (blockIdx.x >> 5), j = MAP == 0 ? (blockIdx.x >> 3) : (blockIdx.x & 31);
        for (int i = 0; i < 10; ++i) {
            if (i < 2) { const int u = i * 32 + j, b = x >> 1, kvh = x & 1; attn_body::attn_unit<8>((long)b * 4096, 4096, kvh * 4 + (u & 3), u >> 2, ROT ? (u * ROT) & 63 : 0, P, O, shm); }
            else { const int gi = x * 8 + (i - 2), b = gi >> 1, kvh = gi & 1; attn_body::attn_unit<8>((long)NTOK_P + (long)b * 2048, 2048, kvh * 4 + (j & 3), j >> 2, ROT ? (j * ROT) & 31 : 0, P, O, shm); }
        }
    } else {
        for (int it = blockIdx.x; it < 2560; it += G) {
            if (it < 512) { const int b = it >> 7, h = (it >> 4) & 7, qb = it & 15; attn_body::attn_unit<8>((long)b * 4096, 4096, h, qb, 0, P, O, shm); }
            else { const int j = it - 512, b = j >> 6, h = (j >> 3) & 7, qb = j & 7; attn_body::attn_unit<8>((long)NTOK_P + (long)b * 2048, 2048, h, qb, 0, P, O, shm); }
        }
    }
}

constexpr int MX_LIST = 36 + 64 + 40 + 256;
__device__ __forceinline__ unsigned* ctl_q(const Args& a, int x) { return (unsigned*)(a.ws + WS_CTL) + 64 * x; }
__device__ __forceinline__ unsigned* ctl_sd(const Args& a, int b, int h) { return (unsigned*)(a.ws + WS_CTL) + 1024 + 64 * (4 * b + h); }
__device__ __forceinline__ unsigned* ctl_pc(const Args& a, int pm) { return (unsigned*)(a.ws + WS_CTL) + 16384 + 64 * pm; }
__device__ __forceinline__ unsigned* ctl_q6(const Args& a, int x) { return (unsigned*)(a.ws + WS_CTL) + 12288 + 64 * x; }
constexpr int CTL_ZERO_WORDS = 16384 + 64 * 320;
__device__ __forceinline__ void mx_publish(const Args& a, int wid, int lane, int pm0, int n, unsigned add) {
    asm volatile("s_waitcnt vmcnt(0)" ::: "memory"); __syncthreads();
    if (wid == 0) { if (!WT_STORES) { __builtin_amdgcn_fence(__ATOMIC_RELEASE, "agent"); asm volatile("s_waitcnt vmcnt(0)" ::: "memory"); } if (lane < n) __hip_atomic_fetch_add(ctl_pc(a, pm0 + lane), add, __ATOMIC_RELAXED, __HIP_MEMORY_SCOPE_AGENT); }
}
struct OutDyn {
    unsigned* qh; unsigned* pcb; volatile LAS unsigned* bc; int x;
    __device__ __forceinline__ bool next(int, pg8::Unit& u) const {
        const int lane = threadIdx.x & 63, wid = __builtin_amdgcn_readfirstlane(threadIdx.x >> 6);
        if (wid == 0) { unsigned v = 0u; if (lane == 0) v = __hip_atomic_fetch_add(qh, 1u, __ATOMIC_RELAXED, __HIP_MEMORY_SCOPE_AGENT); v = (unsigned)__builtin_amdgcn_readfirstlane((int)v); if (lane == 0) bc[0] = v; }
        asm volatile("s_waitcnt lgkmcnt(0)" ::: "memory"); __builtin_amdgcn_s_barrier(); asm volatile("" ::: "memory");
        const int t = __builtin_amdgcn_readfirstlane((int)bc[0]);
        asm volatile("s_waitcnt lgkmcnt(0)" ::: "memory"); __builtin_amdgcn_s_barrier(); asm volatile("" ::: "memory");
#ifdef DBL_OUT
        if (t >= 320) return false; const int t_ = t; const int tq = t_ >= 160 ? t_ - 160 : t_;
#define t tq
#else
        if (t >= 160) return false;
#endif
        const int grp = t >> 5, pi = (t & 31) >> 2; int p0;
#if MX_ORDER
        if (grp == 1) p0 = (x >> 1) * 16 + (x & 1) * 8; else { const int sb = grp == 0 ? 0 : grp - 1; p0 = 64 + (4 * x + sb) * 8; }
#else
        if (grp == 2) p0 = (x >> 1) * 16 + (x & 1) * 8; else { const int sb = grp < 2 ? grp : grp - 1; p0 = 64 + (4 * x + sb) * 8; }
#endif
        u.pm = p0 + pi; u.pn = t & 3; return true;
#ifdef DBL_OUT
#undef t
#endif
    }
    __device__ __forceinline__ void a_ready(const pg8::Unit& u) const {
        const int wid = __builtin_amdgcn_readfirstlane(threadIdx.x >> 6);
        if (wid == 0) { unsigned sp = 0; while ((unsigned)__builtin_amdgcn_readfirstlane((int)__hip_atomic_load(pcb + 64 * u.pm, __ATOMIC_RELAXED, __HIP_MEMORY_SCOPE_AGENT)) < 16u) { __builtin_amdgcn_s_sleep(8); if (++sp > (1u << 22)) break; }
            __builtin_amdgcn_fence(__ATOMIC_ACQUIRE, "agent"); asm volatile("s_waitcnt vmcnt(0)" ::: "memory"); }
        asm volatile("s_waitcnt lgkmcnt(0)" ::: "memory"); __builtin_amdgcn_s_barrier(); asm volatile("" ::: "memory");
    }
    __device__ __forceinline__ void done(const pg8::Unit&) const {}
    __device__ __forceinline__ void between(const pg8::Unit&, const pg8::Unit&) const {}
};
__device__ __forceinline__ unsigned* ctl_hg(const Args& a, int g) { return (unsigned*)(a.ws + WS_CTL) + 45056 + 64 * g; }
__device__ __forceinline__ void norm_share(const Args& a, int g, int j) {
    typedef float f4 __attribute__((ext_vector_type(4)));
    const int lane = threadIdx.x & 63, wave = __builtin_amdgcn_readfirstlane(threadIdx.x >> 6);
    const float* mod = (const float*)(a.ws + WS_MOD); bf16* H = (bf16*)(a.ws + WS_H);
    const int nper = j < 8 ? 2 : 10, m0 = 2048 * g + (j < 8 ? 16 * j : 128 + 80 * (j - 8)) + nper * wave, b = batch_of(2048 * g);
    f4 gs[4], sh[4];
#pragma unroll
    for (int q = 0; q < 4; ++q) { const f4 gg = ((const f4*)a.in[4])[lane + 64 * q], sc = ((const f4*)(mod + b * 3072 + 1024))[lane + 64 * q]; gs[q] = gg * (1.f + sc); sh[q] = ((const f4*)(mod + b * 3072))[lane + 64 * q]; }
#pragma unroll
    for (int rb = 0; rb < 12; rb += 4) {
        if (rb >= nper) break;
        f4 v[4][4];
#pragma unroll
        for (int r = 0; r < 4; ++r) { const int m = m0 + (rb + r < nper ? rb + r : nper - 1);
            const float* x = m < NTOK_P ? a.in[0] + (size_t)m * DM : a.in[1] + (size_t)(m - NTOK_P) * DM;
#pragma unroll
            for (int q = 0; q < 4; ++q) v[r][q] = ((const f4*)x)[lane + 64 * q]; }
        __builtin_amdgcn_sched_barrier(0);
#pragma unroll
        for (int r = 0; r < 4; ++r) { const int m = m0 + (rb + r < nper ? rb + r : nper - 1); float s = 0.f;
#pragma unroll
            for (int q = 0; q < 4; ++q) s += (v[r][q][0] * v[r][q][0] + v[r][q][1] * v[r][q][1]) + (v[r][q][2] * v[r][q][2] + v[r][q][3] * v[r][q][3]);
#pragma unroll
            for (int o = 1; o < 64; o <<= 1) s += __shfl_xor(s, o);
            const float rr = rsqrtf(s * (1.f / DM) + EPS);
#pragma unroll
            for (int q = 0; q < 4; ++q) { const f4 y = v[r][q] * rr * gs[q] + sh[q];
#if TILED_OPERANDS
                unsigned long long* o8q = (unsigned long long*)((unsigned char*)H + pg8::tiled_off(m, 4 * lane + 256 * q, DM));
#else
                unsigned long long* o8q = (unsigned long long*)(H + (size_t)m * DM) + lane + 64 * q;
#endif
                __hip_atomic_store(o8q, (unsigned long long)pk2(y[0], y[1]) | ((unsigned long long)pk2(y[2], y[3]) << 32), __ATOMIC_RELAXED, __HIP_MEMORY_SCOPE_AGENT); } }
        __builtin_amdgcn_sched_barrier(0);
    }
    asm volatile("s_waitcnt vmcnt(0)" ::: "memory"); __builtin_amdgcn_s_barrier(); asm volatile("" ::: "memory");
    if (wave == 0 && lane == 0) __hip_atomic_fetch_add(ctl_hg(a, g), 1u, __ATOMIC_RELAXED, __HIP_MEMORY_SCOPE_AGENT);
}
struct InOrder : pg8::StaticOrder {
    const Args* ap; int x, j;
    __device__ __forceinline__ void a_ready(const pg8::Unit& u) const {
        if (u.pn * 8 + (u.pm & 7) >= 32) return;
        const int g = u.pm >> 3; const int wid = __builtin_amdgcn_readfirstlane(threadIdx.x >> 6);
        if (wid == 0) { unsigned sp = 0; while ((unsigned)__builtin_amdgcn_readfirstlane((int)__hip_atomic_load(ctl_hg(*ap, g), __ATOMIC_RELAXED, __HIP_MEMORY_SCOPE_AGENT)) < 32u) { __builtin_amdgcn_s_sleep(4); if (++sp > (1u << 22)) break; }
            __builtin_amdgcn_fence(__ATOMIC_ACQUIRE, "agent"); asm volatile("s_waitcnt vmcnt(0)" ::: "memory"); }
        asm volatile("s_waitcnt lgkmcnt(0)" ::: "memory"); __builtin_amdgcn_s_barrier(); asm volatile("" ::: "memory");
    }
    __device__ __forceinline__ void between(const pg8::Unit& cur, const pg8::Unit& nxt) const {
        const int gc = cur.pm >> 3, gn = nxt.pm >> 3;
        const int i = ((gc - 5 * x) * 104 + cur.pn * 8 + (cur.pm & 7) - j) >> 5;
        int gs = -1;
        if (i == (j & 1)) gs = 5 * x + 1;
        else if (gn != gc && gn + 1 < 5 * (x + 1)) gs = gn + 1;
        if (gs >= 0) norm_share(*ap, gs, j);
    }
};
struct RetBatch { int cg0, h; __device__ __forceinline__ void item(int i, int& cgl, int& hh) const { cgl = cg0 + i; hh = h; } };
#ifdef TSITEM
__device__ unsigned long long mx_out_dummy;
#define MX_OUT_PARAM , unsigned long long& mx_out
#else
#define MX_OUT_PARAM
#endif
__device__ __forceinline__ void mx_phase(const Args& a, char* shm MX_OUT_PARAM) {
    const int lane = threadIdx.x & 63, wid = __builtin_amdgcn_readfirstlane(threadIdx.x >> 6), x = blockIdx.x & 7;
    volatile LAS unsigned* bc = (volatile LAS unsigned*)((LAS unsigned char*)shm + 131072 + 8192);
#ifdef TSITEM
    unsigned long long mx_acc = 0; int mx_cnt = 0, mx_last_kind = 0;
#endif
    const bf16* P = (const bf16*)(a.ws + WS_PROJ); unsigned char* RT = a.ws + WS_RT; bf16* O = (bf16*)(a.ws + WS_MIX);
    const attn_body::bf16* PA = (const attn_body::bf16*)P; attn_body::bf16* OA = (attn_body::bf16*)O;
    for (;;) {
        if (wid == 0) { unsigned v = 0u; if (lane == 0) v = __hip_atomic_fetch_add(ctl_q(a, x), 1u, __ATOMIC_RELAXED, __HIP_MEMORY_SCOPE_AGENT); v = (unsigned)__builtin_amdgcn_readfirstlane((int)v); if (lane == 0) bc[0] = v; }
        __syncthreads();
        const int idx = __builtin_amdgcn_readfirstlane((int)bc[0]);
        __syncthreads();
        if (idx >= MX_LIST) break;
#ifdef TSITEM
        const int kind_ = (idx < 72 && !(idx & 1)) ? ((idx >> 1) < 4 ? 0 : 1) : idx < 100 ? 2 : 3;
        unsigned long long ti0_ = __builtin_amdgcn_s_memrealtime();
#endif
        const bool is_scan = idx < 72 && !(idx & 1); const int si = idx >> 1;
        if (is_scan) {
            int b, h, dir;
            if (si < 4) { b = x >> 1; h = 2 * (x & 1) + (si >> 1); dir = si & 1; } else { const int t = si - 4; b = 4 + 4 * x + (t >> 3); h = (t >> 1) & 3; dir = t & 1; }
            ret_body::scan_item(b, h, dir, P, RT, a.in[8], a.in[9], shm);
#ifdef DBL_SCAN
            ret_body::scan_item(b, h, dir, P, RT, a.in[8], a.in[9], shm);
#endif
            asm volatile("s_waitcnt vmcnt(0)" ::: "memory"); __syncthreads();
            if (wid == 0) { __builtin_amdgcn_fence(__ATOMIC_RELEASE, "agent"); asm volatile("s_waitcnt vmcnt(0)" ::: "memory"); if (lane == 0) __hip_atomic_fetch_add(ctl_sd(a, b, h), 1u, __ATOMIC_RELAXED, __HIP_MEMORY_SCOPE_AGENT); }
        } else if (idx < 100) {
            const int u = idx < 72 ? si : idx - 36, b = x >> 1, kvh = x & 1;
            attn_body::attn_unit<8>((long)b * 4096, 4096, kvh * 4 + (u & 3), u >> 2, (u * 5) & 63, PA, OA, shm);
#ifdef DBL_ATT
            attn_body::attn_unit<8>((long)b * 4096, 4096, kvh * 4 + (u & 3), u >> 2, (u * 5) & 63, PA, OA, shm);
#endif
            mx_publish(a, wid, lane, b * 16 + (u >> 2), 1, 1u);
        } else {
#if MX_ORDER
            const int r = idx - 100; const bool partA = r < 168; const int slot = partA ? (r * 40) / 168 : 0, first = (slot * 168 + 39) / 40;
#else
            const int r = idx - 100; const bool partA = true; const int slot = (r * 40) / 296, first = (slot * 296 + 39) / 40;
#endif
            if (partA && r == first) {
#ifdef TSITEM
                mx_last_kind = 3;
#endif
#ifdef DBG_SKIP_RET
                continue;
#endif
                int b, h, c0;
                if (slot >= 16 && slot < 24) { const int q = slot - 16; b = x >> 1; h = 2 * (x & 1) + (q >> 2); c0 = 8 * (q & 3); }
                else { const int q = slot < 16 ? slot : slot - 8, pr = q >> 1; b = 4 + 4 * x + (pr >> 2); h = pr & 3; c0 = 8 * (q & 1); }
                if (wid == 0) { unsigned sp = 0; while ((unsigned)__builtin_amdgcn_readfirstlane((int)__hip_atomic_load(ctl_sd(a, b, h), __ATOMIC_RELAXED, __HIP_MEMORY_SCOPE_AGENT)) < 2u) { __builtin_amdgcn_s_sleep(8); if (++sp > (1u << 22)) break; }
                    __builtin_amdgcn_fence(__ATOMIC_ACQUIRE, "agent"); asm volatile("s_waitcnt vmcnt(0)" ::: "memory"); }
                __syncthreads();
                const long rowbase = b < 4 ? (long)b * 4096 : (long)NTOK_P + (long)(b - 4) * 2048;
                const RetBatch S{(int)(rowbase >> 7) + c0, h};
                ret_body::retout_phase<RetBatch, 0>(S, 8, P, RT, O, a.in[8], a.in[9], a.in[10], shm);
#ifdef DBL_RETOUT
                ret_body::retout_phase<RetBatch, 0>(S, 8, P, RT, O, a.in[8], a.in[9], a.in[10], shm);
#endif
                mx_publish(a, wid, lane, (int)(rowbase >> 8) + (c0 >> 1), 4, 2u);
            } else {
#ifdef TSITEM
                mx_last_kind = 4;
#endif
                const int v = partA ? r - slot - 1 : r - 40, gi = 8 * x + (v >> 5), j = v & 31, b = gi >> 1, kvh = gi & 1;
                attn_body::attn_unit<8>((long)NTOK_P + (long)b * 2048, 2048, kvh * 4 + (j & 3), j >> 2, (j * 5) & 31, PA, OA, shm);
#ifdef DBL_ATT
                attn_body::attn_unit<8>((long)NTOK_P + (long)b * 2048, 2048, kvh * 4 + (j & 3), j >> 2, (j * 5) & 31, PA, OA, shm);
#endif
                mx_publish(a, wid, lane, 64 + b * 8 + (j >> 2), 1, 1u);
            }
        }
#ifdef TSITEM
        { const unsigned long long d_ = __builtin_amdgcn_s_memrealtime() - ti0_; int k2_ = kind_; if (kind_ == 3) k2_ = mx_last_kind; if (k2_ == TSITEM && mx_cnt == 0) { mx_acc += d_; mx_cnt = 1; } }
#endif
    }
#ifdef TSITEM
    mx_out = mx_acc;
#endif
}
__global__ void __launch_bounds__(NTHREADS, 2) mk_fwd(Args a) {
    extern __shared__ __attribute__((aligned(16))) unsigned char lds_raw[];
    LAS unsigned char* lds = (LAS unsigned char*)lds_raw;
    const int lo = a.ph_lo, hi = a.ph_hi;
#ifdef TSLO
    unsigned long long ts0 = 0, ts1 = 0;
#define TS(k) do { if ((k) == TSLO) ts0 = __builtin_amdgcn_s_memrealtime(); if ((k) == TSHI) ts1 = __builtin_amdgcn_s_memrealtime(); } while (0)
#else
#define TS(k) do {} while (0)
#endif
    TS(0);
    { LAS unsigned* xst = (LAS unsigned*)(lds + LDS_PERSIST); if (threadIdx.x < 2) xst[threadIdx.x] = 0u; }
    __syncthreads();
    XcdBarrier bar = xcd_barrier_post((unsigned*)(a.ws + WS_CTL) + 40960, (volatile LAS unsigned*)(lds + LDS_PERSIST));
#define IN(k) (lo <= (k) && (k) < hi)
#define SEAM(k) do { if (IN(k) && IN((k) + 1)) { xcd_barrier(bar); } } while (0)
    if (IN(0)) { p0_prologue(a, lds); }
    TS(1);
    SEAM(0);
    TS(2);
#if FUSED_NORM
    if (IN(2)) {
        pg8::Gemm g{(const bf16*)(a.ws + WS_H), (const bf16*)(a.ws + WS_WIN), M, INC, DM};
        InOrder S; S.init(M, INC, gridDim.x, (int)blockIdx.x); S.ap = &a; S.x = blockIdx.x & 7; S.j = blockIdx.x >> 3;
        const float* tabR = (const float*)(a.ws + WS_TAB);
        { LAS float* tl = (LAS float*)(lds + 131072); for (int i = threadIdx.x; i < 4096; i += NTHREADS) tl[i] = tabR[i];
          LAS float* ta = (LAS float*)(lds + LDS_TABA); for (int i = threadIdx.x; i < 2048; i += NTHREADS) ta[i] = tabR[4096 + i]; __syncthreads(); }
        norm_share(a, 5 * S.x, S.j);
#ifndef P2F_DEPHASE_TICKS
#define P2F_DEPHASE_TICKS 0
#endif
#if P2F_DEPHASE_TICKS > 0
        if (gridDim.x == 256 && blockIdx.x >= 64) { const unsigned long long t0 = __builtin_amdgcn_s_memrealtime(); const unsigned long long ticks = (unsigned long long)((blockIdx.x >> 3) & 3) * P2F_DEPHASE_TICKS; while (__builtin_amdgcn_s_memrealtime() - t0 < ticks) __builtin_amdgcn_s_sleep(16); }
#endif
        pg8::EpiIn E{(bf16*)(a.ws + WS_PROJ), (const LAS float*)(lds + 131072), (const LAS float*)(lds + LDS_TABA), a.in[11], a.in[12]};
        TS(3);
        pg8::gemm_phase<pg8::EpiIn, InOrder, true, true>(lds, g, S, E);
        TS(4);
#ifdef DBL_P2
        { pg8::StaticOrder S2; S2.init(M, INC, gridDim.x, (int)blockIdx.x); pg8::gemm_phase<pg8::EpiIn, pg8::StaticOrder, true, true>(lds, g, S2, E); }
#endif
    }
#else
    if (IN(1)) { p1_norm(a); }
    SEAM(1);
    if (IN(2)) {
        pg8::Gemm g{(const bf16*)(a.ws + WS_H), (const bf16*)(a.ws + WS_WIN), M, INC, DM}; pg8::StaticOrder S; S.init(M, INC, gridDim.x, (int)blockIdx.x);
        const float* tabR = (const float*)(a.ws + WS_TAB);
        { LAS float* tl = (LAS float*)(lds + 131072); for (int i = threadIdx.x; i < 4096; i += NTHREADS) tl[i] = tabR[i]; __syncthreads(); }
        pg8::EpiIn E{(bf16*)(a.ws + WS_PROJ), (const LAS float*)(lds + 131072), (const LAS float*)(lds + LDS_TABA), a.in[11], a.in[12]};
#ifndef P2_DEPHASE_TICKS
#define P2_DEPHASE_TICKS 875
#endif
        if (P2_DEPHASE_TICKS > 0 && gridDim.x == 256 && blockIdx.x >= 64) { const unsigned long long t0 = __builtin_amdgcn_s_memrealtime(); const unsigned long long ticks = (unsigned long long)((blockIdx.x >> 3) & 3) * P2_DEPHASE_TICKS;
            while (__builtin_amdgcn_s_memrealtime() - t0 < ticks) __builtin_amdgcn_s_sleep(16); }
#ifdef P2_PAD_NOPS
        asm volatile(P2_PAD_NOPS);
#endif
        pg8::gemm_phase<pg8::EpiIn, pg8::StaticOrder, true, true>(lds, g, S, E);
    }
#endif
    SEAM(2);
    TS(5);
#if MERGED_MIX
#ifdef TSITEM
    unsigned long long mxo = 0;
    if (IN(3)) { mx_phase(a, (char*)lds_raw, mxo); }
#else
    if (IN(3)) { mx_phase(a, (char*)lds_raw); }
#endif
    TS(6);
#else
    if (IN(3)) { p3_scan(a, (char*)lds_raw); }
    SEAM(3);
    if (IN(4)) { p4_retout<0>(a, (char*)lds_raw); }
    if (IN(5)) { p5_attn<0, 5>(a, (char*)lds_raw); }
#endif
#if MERGED_MIX && DYN_OUT
    if (IN(6)) {
        pg8::Gemm g{(const bf16*)(a.ws + WS_MIX), (const bf16*)(a.ws + WS_WOUT), M, DM, DM};
        const OutDyn S{ctl_q6(a, blockIdx.x & 7), ctl_pc(a, 0), (volatile LAS unsigned*)(lds + 131072 + 8192), (int)(blockIdx.x & 7)};
        pg8::EpiOut E{a.in[0], a.in[1], (const float*)(a.ws + WS_MOD), a.out};
        pg8::gemm_phase<pg8::EpiOut, OutDyn, true, true>(lds, g, S, E);
    }
    TS(7);
#ifdef TSITEM
    if ((int)blockIdx.x == TSBLOCK) { const unsigned long long d = mxo * TSMUL, t0 = __builtin_amdgcn_s_memrealtime(); while (__builtin_amdgcn_s_memrealtime() - t0 < d) __builtin_amdgcn_s_sleep(32); }
#endif
#ifdef TSLO
    if ((int)blockIdx.x == TSBLOCK) { const unsigned long long d = (ts1 - ts0) * TSMUL, t0 = __builtin_amdgcn_s_memrealtime(); while (__builtin_amdgcn_s_memrealtime() - t0 < d) __builtin_amdgcn_s_sleep(32); }
#endif
#else
    SEAM(5);
    if (IN(6)) {
        pg8::Gemm g{(const bf16*)(a.ws + WS_MIX), (const bf16*)(a.ws + WS_WOUT), M, DM, DM}; pg8::StaticOrder S; S.init(M, DM, gridDim.x, (int)blockIdx.x);
        pg8::EpiOut E{a.in[0], a.in[1], (const float*)(a.ws + WS_MOD), a.out};
#ifdef P6_DEPHASE_TICKS
        { const unsigned long long t0 = __builtin_amdgcn_s_memrealtime(); const unsigned long long ticks = (unsigned long long)((blockIdx.x >> 3) & 3) * P6_DEPHASE_TICKS; while (__builtin_amdgcn_s_memrealtime() - t0 < ticks) __builtin_amdgcn_s_sleep(16); }
#endif
        pg8::gemm_phase<pg8::EpiOut, pg8::StaticOrder, true, true>(lds, g, S, E);
    }
#endif
#undef IN
#undef SEAM
}

__device__ __forceinline__ void p2_plain(const Args& a, LAS unsigned char* lds, int mode) {
    pg8::Gemm g{(const bf16*)(a.ws + WS_H), (const bf16*)(a.ws + WS_WIN), M, INC, DM}; pg8::StaticOrder S; S.init(M, INC, gridDim.x, (int)blockIdx.x);
    pg8::EpiPlain E{(bf16*)(a.ws + WS_PROJ), mode};
    pg8::gemm_phase<pg8::EpiPlain, pg8::StaticOrder, true, true>(lds, g, S, E);
}
__device__ __forceinline__ void p2_real(const Args& a, LAS unsigned char* lds) {
    pg8::Gemm g{(const bf16*)(a.ws + WS_H), (const bf16*)(a.ws + WS_WIN), M, INC, DM}; pg8::StaticOrder S; S.init(M, INC, gridDim.x, (int)blockIdx.x);
    const float* tabR = (const float*)(a.ws + WS_TAB);
    { LAS float* tl = (LAS float*)(lds + 131072); for (int i = threadIdx.x; i < 4096; i += NTHREADS) tl[i] = tabR[i]; __syncthreads(); }
    pg8::EpiIn E{(bf16*)(a.ws + WS_PROJ), (const LAS float*)(lds + 131072), (const LAS float*)(lds + LDS_TABA), a.in[11], a.in[12]};
    pg8::gemm_phase<pg8::EpiIn, pg8::StaticOrder, true, true>(lds, g, S, E);
}
#ifdef PROBE_EXP
__global__ void __launch_bounds__(NTHREADS, 2) mk_probe(Args a) {
    extern __shared__ __attribute__((aligned(16))) unsigned char lds_raw[];
    PROBE_EXP;
}
#endif
extern "C" void kernel_launch(void* const* d_in, const int* in_sizes, int n_in, void* d_out, int out_size, void* d_ws, size_t ws_size, hipStream_t stream) {
    static int grid = 0;
    if (grid == 0) {
        int dev = 0, cus = 0, per_cu = 0;
        hipGetDevice(&dev); hipDeviceGetAttribute(&cus, hipDeviceAttributeMultiprocessorCount, dev);
        hipFuncSetAttribute((const void*)mk_fwd, hipFuncAttributeMaxDynamicSharedMemorySize, LDS_BYTES);
        if (hipOccupancyMaxActiveBlocksPerMultiprocessor(&per_cu, (const void*)mk_fwd, NTHREADS, LDS_BYTES) != hipSuccess || per_cu < 1) {
            fprintf(stderr, "kernel_launch: occupancy query reports %d workgroups per CU; nothing launched\n", per_cu); grid = -1; }
        else if (cus != 256) { fprintf(stderr, "kernel_launch: built for a 256-CU device (8 x 32 work queues); this device reports %d CUs; nothing launched\n", cus); grid = -1; }
        else grid = cus;
        (void)hipGetLastError();
        if (ws_size < WS_END || n_in != 14) { fprintf(stderr, "kernel_launch: workspace too small (%zu < %zu) or n_in %d != 14\n", ws_size, (size_t)WS_END, n_in); grid = -1; }
    }
    if (grid < 0) return;
    Args a{};
    for (int i = 0; i < 14; ++i) a.in[i] = (const float*)d_in[i];
    a.out = (float*)d_out; a.ws = (unsigned char*)d_ws; a.ph_lo = 0; a.ph_hi = 7;
    if (hipMemsetAsync((char*)d_ws + WS_CTL, 0, CTL_ZERO_BYTES, stream) != hipSuccess) { fprintf(stderr, "kernel_launch: memset of the control words failed\n"); return; }
    hipLaunchKernelGGL(mk_fwd, dim3(grid), dim3(NTHREADS), LDS_BYTES, stream, a);
    { const hipError_t e = hipPeekAtLastError(); if (e != hipSuccess) fprintf(stderr, "kernel_launch: launch failed: %s (grid %d)\n", hipGetErrorString(e), grid); }
#ifdef PROBE_EXP
    { hipFuncSetAttribute((const void*)mk_probe, hipFuncAttributeMaxDynamicSharedMemorySize, LDS_BYTES); hipLaunchKernelGGL(mk_probe, dim3(grid), dim3(NTHREADS), LDS_BYTES, stream, a); }
#endif
#ifdef PROBE_PHASE
    hipMemsetAsync((char*)d_ws + WS_CTL, 0, 65536, stream);
    { Args a2 = a; a2.ph_lo = PROBE_PHASE; a2.ph_hi = PROBE_PHASE + 1; hipLaunchKernelGGL(mk_fwd, dim3(grid), dim3(NTHREADS), LDS_BYTES, stream, a2); }
#endif
}
```
